# Optimizing an MI355X kernel written in HIP

```python
import math
import numpy as np
import jax
import jax.numpy as jnp
from jax import lax

D_MODEL = 1024
BATCH = 32
SEQ = 256
DEPTH = 4
DEC_BATCH = 2
DEC_SEQ = 2048
PAST_LEN = 256

GRID_W = 64
HEAD_DIM = 64
N_HEADS_TOTAL = D_MODEL // HEAD_DIM
A_HEADS = 3 * N_HEADS_TOTAL // 8
A_KV_HEADS = A_HEADS // 3
B_HEADS = N_HEADS_TOTAL // 4
C_HEADS = N_HEADS_TOTAL - A_HEADS - B_HEADS
A_WIDTH = A_HEADS * HEAD_DIM
A_KV_WIDTH = A_KV_HEADS * HEAD_DIM
B_WIDTH = B_HEADS * HEAD_DIM
C_WIDTH = C_HEADS * HEAD_DIM
MIX_WIDTH = A_WIDTH + B_WIDTH + C_WIDTH
N_DIR = 2
CONV_K = 3
CHUNK = 64
Q_BLOCK = 128
WIN_R = 8
WIN_C = 16
ROPE_THETA = 10000.0
D_FF = 256 * math.ceil(8 * D_MODEL / (3 * 256))
N_MOD = 6
PROJ_SPLITS = (A_WIDTH, A_KV_WIDTH, A_KV_WIDTH, 3 * B_WIDTH, B_WIDTH,
               N_DIR * B_HEADS, N_DIR * B_HEADS, C_WIDTH, C_WIDTH, C_WIDTH)
IN_WIDTH = sum(PROJ_SPLITS)
EPS = 1e-6

kernel_name = 'hybrid_flow_trunk_step'


def rmsnorm(x, g):
    xf = x.astype(jnp.float32)
    y = xf * lax.rsqrt(jnp.mean(xf * xf, axis=-1, keepdims=True) + EPS)
    return (y * g.astype(jnp.float32)).astype(x.dtype)


def l2norm(x):
    return x * lax.rsqrt(jnp.sum(x * x, axis=-1, keepdims=True) + EPS)


def axial_rope(x):
    s, d = x.shape[1], x.shape[-1]
    quarter = d // 4
    inv = ROPE_THETA ** (-jnp.arange(quarter, dtype=jnp.float32) / quarter)
    t = jnp.arange(s)
    row = (t // GRID_W).astype(jnp.float32)
    col = (t % GRID_W).astype(jnp.float32)
    ang = jnp.concatenate([row[:, None] * inv, col[:, None] * inv], axis=-1)
    cos = jnp.cos(ang)[None, :, None, :]
    sin = jnp.sin(ang)[None, :, None, :]
    xf = x.astype(jnp.float32)
    x1, x2 = xf[..., : d // 2], xf[..., d // 2:]
    return jnp.concatenate([x1 * cos - x2 * sin, x1 * sin + x2 * cos], axis=-1).astype(x.dtype)


def modulation(cvec, w_mod, b_mod):
    m = jax.nn.silu(cvec) @ w_mod + b_mod
    return jnp.split(m[..., None, :], N_MOD, axis=-1)


def split_projection(z):
    idx = np.cumsum(PROJ_SPLITS)[:-1].tolist()
    return jnp.split(z, idx, axis=-1)


def blocked_attention(q, k, v):
    b, s, hq, d = q.shape
    hkv = k.shape[2]
    grp = hq // hkv
    nb = s // Q_BLOCK
    qb = jnp.moveaxis(q.reshape(b, nb, Q_BLOCK, hkv, grp, d), 1, 0)
    scale = d ** -0.5

    def one_block(q_blk):
        sc = jnp.einsum('bqhgd,bkhd->bhgqk', q_blk, k).astype(jnp.float32) * scale
        p = jax.nn.softmax(sc, axis=-1).astype(v.dtype)
        return jnp.einsum('bhgqk,bkhd->bqhgd', p, v)

    o = lax.map(one_block, qb)
    return jnp.moveaxis(o, 0, 1).reshape(b, s, hq * d)


def neighbourhood_attention(q, k, v, k_ctx, v_ctx, rpb):
    b, s, h, d = q.shape
    rows = s // GRID_W
    wr = min(WIN_R, rows)
    r = jnp.arange(rows)
    r_start = jnp.clip(r - wr // 2, 0, rows - wr)
    ridx = r_start[:, None] + jnp.arange(wr)[None, :]
    col = jnp.arange(GRID_W)
    c_start = jnp.clip(col - WIN_C // 2, 0, GRID_W - WIN_C)
    cmask = (col[None, :] >= c_start[:, None]) & (col[None, :] < c_start[:, None] + WIN_C)
    mask = jnp.broadcast_to(cmask[:, None, :], (GRID_W, wr, GRID_W)).reshape(GRID_W, wr * GRID_W)
    qg = q.reshape(b, rows, GRID_W, h, d)
    kg = k.reshape(b, rows, GRID_W, h, d)[:, ridx].reshape(b, rows, wr * GRID_W, h, d)
    vg = v.reshape(b, rows, GRID_W, h, d)[:, ridx].reshape(b, rows, wr * GRID_W, h, d)
    dr = ridx - r[:, None] + (WIN_R - 1)
    dc = jnp.clip(col[None, :] - col[:, None] + (WIN_C - 1), 0, 2 * WIN_C - 2)
    bias = rpb[:, dr[:, None, :, None], dc[None, :, None, :]]
    bias = bias.reshape(h, rows, GRID_W, wr * GRID_W).astype(jnp.float32)
    scale = d ** -0.5
    s_loc = jnp.einsum('brqhd,brkhd->bhrqk', qg, kg).astype(jnp.float32) * scale + bias[None]
    s_loc = jnp.where(mask, s_loc, -jnp.inf)
    s_ctx = jnp.einsum('brqhd,bkhd->bhrqk', qg, k_ctx).astype(jnp.float32) * scale
    p = jax.nn.softmax(jnp.concatenate([s_loc, s_ctx], axis=-1), axis=-1).astype(v.dtype)
    p_loc, p_ctx = p[..., : wr * GRID_W], p[..., wr * GRID_W:]
    o = jnp.einsum('bhrqk,brkhd->brqhd', p_loc, vg) + jnp.einsum('bhrqk,bkhd->brqhd', p_ctx, v_ctx)
    return o.reshape(b, s, h * d)


def gated_delta_chunked(q, k, v, g, beta, s0):
    b, L, h, d = q.shape
    n = L // CHUNK

    def blocks(t):
        t = t.reshape((b, n, CHUNK, h) + t.shape[3:])
        return jnp.moveaxis(jnp.swapaxes(t, 2, 3), 1, 0)

    qc, kc, vc, bc = blocks(q), blocks(k), blocks(v), blocks(beta)
    gc = jnp.cumsum(blocks(g), axis=-1)
    tril = jnp.tril(jnp.ones((CHUNK, CHUNK), dtype=bool))
    strict = jnp.tril(jnp.ones((CHUNK, CHUNK), dtype=bool), -1)
    decay = jnp.exp(jnp.where(tril, gc[..., :, None] - gc[..., None, :], -jnp.inf))
    kb = kc * bc[..., None]
    lmat = jnp.where(strict, jnp.einsum('nbhid,nbhjd->nbhij', kb, kc) * decay, 0.0)
    rhs = jnp.concatenate([vc * bc[..., None], kb * jnp.exp(gc)[..., None]], axis=-1)
    sol = lax.linalg.triangular_solve(lmat + jnp.eye(CHUNK, dtype=lmat.dtype), rhs,
                                      left_side=True, lower=True, unit_diagonal=True)
    u, w = jnp.split(sol, 2, axis=-1)
    a_intra = jnp.where(tril, jnp.einsum('nbhid,nbhjd->nbhij', qc, kc) * decay, 0.0)

    def step(s, xs):
        q_i, k_i, u_i, w_i, g_i, a_i = xs
        v_new = u_i - w_i @ s
        o_i = (q_i * jnp.exp(g_i)[..., None]) @ s + a_i @ v_new
        g_last = g_i[..., -1:]
        s = s * jnp.exp(g_last)[..., None] + jnp.einsum(
            'bhcd,bhce->bhde', k_i * jnp.exp(g_last - g_i)[..., None], v_new)
        return s, o_i

    s_fin, o = lax.scan(step, s0, (qc, kc, u, w, gc, a_intra))
    o = jnp.swapaxes(jnp.moveaxis(o, 0, 1), 2, 3).reshape(b, L, h, d)
    return o, s_fin


def deltanet_prep(b_qkv, b_beta, b_alpha, conv_w, a_log, dt_bias):
    b, L, _ = b_qkv.shape
    pad = CONV_K // 2
    xp = jnp.pad(b_qkv, ((0, 0), (pad, pad), (0, 0)))
    y = xp[:, 0:L] * conv_w[0]
    for j in range(1, CONV_K):
        y = y + xp[:, j:j + L] * conv_w[j]
    y = jax.nn.silu(y).astype(jnp.float32)
    q, k, v = jnp.split(y, 3, axis=-1)
    q = l2norm(q.reshape(b, L, B_HEADS, HEAD_DIM)) * (HEAD_DIM ** -0.5)
    k = l2norm(k.reshape(b, L, B_HEADS, HEAD_DIM))
    v = v.reshape(b, L, B_HEADS, HEAD_DIM)
    beta = jax.nn.sigmoid(b_beta.astype(jnp.float32)).reshape(b, L, N_DIR, B_HEADS)
    g = -jnp.exp(a_log.astype(jnp.float32)) * jax.nn.softplus(
        b_alpha.astype(jnp.float32).reshape(b, L, N_DIR, B_HEADS) + dt_bias.astype(jnp.float32))
    return q, k, v, beta, g


def bidir_delta(q, k, v, beta, g, s0_fwd, s0_bwd):
    o_f, s_f = gated_delta_chunked(q, k, v, g[:, :, 0], beta[:, :, 0], s0_fwd)
    o_b, s_b = gated_delta_chunked(q[:, ::-1], k[:, ::-1], v[:, ::-1],
                                   g[:, ::-1, 1], beta[:, ::-1, 1], s0_bwd)
    return o_f + o_b[:, ::-1], jnp.stack([s_f, s_b], axis=1)


def deltanet_out(o, b_g, g_onorm):
    b, L = o.shape[:2]
    gate = jax.nn.silu(b_g.astype(jnp.float32)).reshape(b, L, B_HEADS, HEAD_DIM)
    return (rmsnorm(o, g_onorm) * gate).reshape(b, L, B_WIDTH)


def merge_groups(o_a, o_b, o_c, g_out_a, g_out_c, w_out):
    y = jnp.concatenate([rmsnorm(o_a, g_out_a), o_b.astype(o_a.dtype), rmsnorm(o_c, g_out_c)], axis=-1)
    return y @ w_out


def context_mixer(h, w_in, g_qk_a, g_out_a, conv_w, a_log, dt_bias, g_onorm_b, g_out_c, w_out):
    b, L, _ = h.shape
    a_q, a_k, a_v, b_qkv, b_g, b_beta, b_alpha, c_q, c_k, c_v = split_projection(h @ w_in)
    qa = rmsnorm(a_q.reshape(b, L, A_HEADS, HEAD_DIM), g_qk_a[0])
    ka = rmsnorm(a_k.reshape(b, L, A_KV_HEADS, HEAD_DIM), g_qk_a[1])
    va = a_v.reshape(b, L, A_KV_HEADS, HEAD_DIM)
    o_a = blocked_attention(qa, ka, va)
    q, k, v, beta, g = deltanet_prep(b_qkv, b_beta, b_alpha, conv_w, a_log, dt_bias)
    zero = jnp.zeros((b, B_HEADS, HEAD_DIM, HEAD_DIM), jnp.float32)
    o_b, s_b = bidir_delta(q, k, v, beta, g, zero, zero)
    o_b = deltanet_out(o_b, b_g, g_onorm_b)
    qc = c_q.reshape(b, L, C_HEADS, HEAD_DIM)
    kc = c_k.reshape(b, L, C_HEADS, HEAD_DIM)
    vc = c_v.reshape(b, L, C_HEADS, HEAD_DIM)
    o_c = blocked_attention(qc, kc, vc)
    m = merge_groups(o_a, o_b, o_c, g_out_a, g_out_c, w_out)
    return m, (ka, va, s_b, kc, vc)


def latent_mixer(h, ka_ctx, va_ctx, s_ctx, kc_ctx, vc_ctx, w_in, g_qk_a, g_out_a, conv_w, a_log,
                 dt_bias, g_onorm_b, rpb, g_out_c, w_out):
    b, L, _ = h.shape
    dt = h.dtype
    a_q, a_k, a_v, b_qkv, b_g, b_beta, b_alpha, c_q, c_k, c_v = split_projection(h @ w_in)
    qa = axial_rope(rmsnorm(a_q.reshape(b, L, A_HEADS, HEAD_DIM), g_qk_a[0]))
    ka = axial_rope(rmsnorm(a_k.reshape(b, L, A_KV_HEADS, HEAD_DIM), g_qk_a[1]))
    va = a_v.reshape(b, L, A_KV_HEADS, HEAD_DIM)
    o_a = blocked_attention(qa, jnp.concatenate([ka, ka_ctx.astype(dt)], axis=1),
                            jnp.concatenate([va, va_ctx.astype(dt)], axis=1))
    q, k, v, beta, g = deltanet_prep(b_qkv, b_beta, b_alpha, conv_w, a_log, dt_bias)
    s_ctx = s_ctx.astype(jnp.float32)
    o_b, _ = bidir_delta(q, k, v, beta, g, s_ctx[:, 0], s_ctx[:, 1])
    o_b = deltanet_out(o_b, b_g, g_onorm_b)
    o_c = neighbourhood_attention(c_q.reshape(b, L, C_HEADS, HEAD_DIM), c_k.reshape(b, L, C_HEADS, HEAD_DIM),
                                  c_v.reshape(b, L, C_HEADS, HEAD_DIM), kc_ctx.astype(dt), vc_ctx.astype(dt), rpb)
    return merge_groups(o_a, o_b, o_c, g_out_a, g_out_c, w_out)


def sandwich_block(x, mod, g_norm, mixer, w_gu, w_down):
    sh1, sc1, gt1, sh2, sc2, gt2 = mod
    h = rmsnorm(x, g_norm[0]) * (1.0 + sc1) + sh1
    m, extra = mixer(h)
    x = x + gt1 * rmsnorm(m, g_norm[1])
    h = rmsnorm(x, g_norm[2]) * (1.0 + sc2) + sh2
    gate, up = jnp.split(h @ w_gu, 2, axis=-1)
    f = (jax.nn.silu(gate) * up) @ w_down
    x = x + gt2 * rmsnorm(f, g_norm[3])
    return x, extra


def setup_inputs(seed: int = 0) -> dict:
    key = jax.random.key(seed)
    ks = jax.random.split(key, 26)
    f32 = jnp.float32
    D = D_MODEL

    def nrm(k, shape, s):
        return s * jax.random.normal(k, shape, f32)

    a_log = jnp.log(jax.random.uniform(ks[20], (DEPTH, N_DIR, B_HEADS), f32, 1.0, 16.0))
    dtv = jnp.exp(jax.random.uniform(ks[21], (DEPTH, N_DIR, B_HEADS), f32, math.log(1e-3), math.log(0.1)))
    dt_bias = dtv + jnp.log(-jnp.expm1(-dtv))
    return {
        'x_prompt': nrm(ks[0], (BATCH, SEQ, D), 1.0),
        'x_sample': nrm(ks[1], (DEC_BATCH, DEC_SEQ, D), 1.0),
        'cache_a_k': nrm(ks[2], (DEC_BATCH, DEPTH, PAST_LEN, A_KV_HEADS, HEAD_DIM), 1.0),
        'cache_a_v': nrm(ks[3], (DEC_BATCH, DEPTH, PAST_LEN, A_KV_HEADS, HEAD_DIM), 1.0),
        'state_b': nrm(ks[4], (DEC_BATCH, DEPTH, N_DIR, B_HEADS, HEAD_DIM, HEAD_DIM), HEAD_DIM ** -0.5),
        'cache_c_k': nrm(ks[5], (DEC_BATCH, DEPTH, PAST_LEN, C_HEADS, HEAD_DIM), 1.0),
        'cache_c_v': nrm(ks[6], (DEC_BATCH, DEPTH, PAST_LEN, C_HEADS, HEAD_DIM), 1.0),
        'c': nrm(ks[7], (DEC_BATCH, D), 1.0),
        'c_ctx': nrm(ks[8], (D,), 1.0),
        'w_mod': nrm(ks[9], (DEPTH, D, N_MOD * D), 0.5 * D ** -0.5),
        'b_mod': nrm(ks[10], (DEPTH, N_MOD * D), 0.01),
        'g_norm': 1.0 + nrm(ks[11], (DEPTH, 4, D), 0.05),
        'w_in': nrm(ks[12], (DEPTH, D, IN_WIDTH), D ** -0.5),
        'g_qk_a': 1.0 + nrm(ks[13], (DEPTH, 2, HEAD_DIM), 0.05),
        'g_out_a': 1.0 + nrm(ks[14], (DEPTH, A_WIDTH), 0.05),
        'conv_w': nrm(ks[15], (DEPTH, CONV_K, 3 * B_WIDTH), CONV_K ** -0.5),
        'a_log': a_log,
        'dt_bias': dt_bias,
        'g_onorm_b': 1.0 + nrm(ks[16], (DEPTH, HEAD_DIM), 0.05),
        'rpb': nrm(ks[17], (DEPTH, C_HEADS, 2 * WIN_R - 1, 2 * WIN_C - 1), 0.1),
        'g_out_c': 1.0 + nrm(ks[18], (DEPTH, C_WIDTH), 0.05),
        'w_out': nrm(ks[19], (DEPTH, MIX_WIDTH, D), MIX_WIDTH ** -0.5),
        'w_gu': nrm(ks[22], (DEPTH, D, 2 * D_FF), D ** -0.5),
        'w_down': nrm(ks[23], (DEPTH, D_FF, D), D_FF ** -0.5),
    }


def reference(x_prompt, x_sample, cache_a_k, cache_a_v, state_b, cache_c_k, cache_c_v, c, c_ctx,
              w_mod, b_mod, g_norm, w_in, g_qk_a, g_out_a, conv_w, a_log, dt_bias, g_onorm_b, rpb,
              g_out_c, w_out, w_gu, w_down):
    xp = x_prompt
    xs = x_sample
    ka_l, va_l, sb_l, kc_l, vc_l = [], [], [], [], []
    for l in range(DEPTH):
        mod_p = modulation(c_ctx, w_mod[l], b_mod[l])
        xp, ctx_t = sandwich_block(
            xp, mod_p, g_norm[l],
            lambda h: context_mixer(h, w_in[l], g_qk_a[l], g_out_a[l], conv_w[l], a_log[l], dt_bias[l],
                                    g_onorm_b[l], g_out_c[l], w_out[l]),
            w_gu[l], w_down[l])
        ka_l.append(ctx_t[0])
        va_l.append(ctx_t[1])
        sb_l.append(ctx_t[2])
        kc_l.append(ctx_t[3])
        vc_l.append(ctx_t[4])
        mod_s = modulation(c, w_mod[l], b_mod[l])
        xs, _ = sandwich_block(
            xs, mod_s, g_norm[l],
            lambda h: (latent_mixer(h, cache_a_k[:, l], cache_a_v[:, l], state_b[:, l], cache_c_k[:, l],
                                    cache_c_v[:, l], w_in[l], g_qk_a[l], g_out_a[l], conv_w[l], a_log[l],
                                    dt_bias[l], g_onorm_b[l], rpb[l], g_out_c[l], w_out[l]), None),
            w_gu[l], w_down[l])
    new_cache_a_k = jnp.stack(ka_l, axis=1)
    new_cache_a_v = jnp.stack(va_l, axis=1)
    new_state_b = jnp.stack(sb_l, axis=1)
    new_cache_c_k = jnp.stack(kc_l, axis=1)
    new_cache_c_v = jnp.stack(vc_l, axis=1)
    return (xp, xs, new_cache_a_k, new_cache_a_v, new_state_b, new_cache_c_k, new_cache_c_v)
```

```cpp
#include <hip/hip_runtime.h>
#include <hip/hip_cooperative_groups.h>
#include <cstdio>
#include <cstdint>
namespace cg = cooperative_groups;

#ifndef DBG_LAYERS
#define DBG_LAYERS 4
#endif

typedef unsigned short bf16;
typedef short bf16x8 __attribute__((ext_vector_type(8)));
typedef float f32x4 __attribute__((ext_vector_type(4)));

constexpr int D = 1024, TCTX = 8192, TLAT = 4096, T = TCTX + TLAT, NL = 4;
constexpr int SEQ = 256, LSEQ = 2048, NB_CTX = 32, NB_LAT = 2;
constexpr int INW = 2832, INWP = 2944, ZW = 1680, CW = 1152, DFF = 2816, GUW = 5632;
constexpr int NTHR = 512;
constexpr float EPS = 1e-6f;

constexpr int ZC_AQ = 0, ZC_AK = 384, ZC_AV = 512, ZC_BQKV = 640, ZC_BG = 1408, ZC_BBETA = 1664, ZC_BALPHA = 1672;
constexpr int PC_CQ = 1680, PC_CK = 2064, PC_CV = 2448;

constexpr size_t OUT_Y = 0;
constexpr size_t OUT_AK = 12582912, OUT_AV = 16777216, OUT_SB = 20971520, OUT_CK = 25165824, OUT_CV = 37748736;

constexpr size_t al256(size_t x) { return (x + 255) & ~(size_t)255; }
constexpr size_t WS_CTR = 0;
constexpr size_t WS_MOD = 4096;
constexpr size_t WS_ROPE = al256(WS_MOD + (size_t)NL * 3 * 6144 * 4);
constexpr size_t WS_CAK = al256(WS_ROPE + 2 * 64 * 16 * 4);
constexpr size_t WS_CAV = WS_CAK + (size_t)2 * 4 * 256 * 128 * 2;
constexpr size_t WS_CCK = WS_CAV + (size_t)2 * 4 * 256 * 128 * 2;
constexpr size_t WS_CCV = WS_CCK + (size_t)2 * 4 * 256 * 384 * 2;
constexpr size_t WS_WIN = al256(WS_CCV + (size_t)2 * 4 * 256 * 384 * 2);
constexpr size_t WS_WOUT = WS_WIN + (size_t)INWP * D * 2;
constexpr size_t WS_WGU = WS_WOUT + (size_t)D * D * 2;
constexpr size_t WS_WDN = WS_WGU + (size_t)GUW * D * 2;
constexpr size_t WS_HY = al256(WS_WDN + (size_t)D * DFF * 2);
constexpr size_t WS_Z = WS_HY + (size_t)T * D * 2;
constexpr size_t WS_CQKV = WS_Z + (size_t)T * ZW * 4;
constexpr size_t WS_QKA = WS_CQKV + (size_t)T * CW * 2;
constexpr size_t WS_D1 = WS_QKA + (size_t)T * 640 * 2;
constexpr int NCD = 1536;
constexpr size_t WS_DEC = WS_D1 + (size_t)NCD * 5 * 4096 * 4;
constexpr size_t WS_OB = al256(WS_DEC + NCD * 4);
constexpr size_t WS_O = WS_OB + (size_t)2 * T * 256 * 4;
constexpr size_t WS_END = WS_O + (size_t)T * 768 * 2;
static_assert((size_t)T * DFF * 2 <= (size_t)NCD * 5 * 4096 * 4, "ACT aliases D1");
static_assert((size_t)T * D * 4 <= (size_t)T * ZW * 4, "M/F alias Z");

constexpr int LDS_BYTES = 122880;

struct Params {
    const float* in[24];
    float* out;
    unsigned char* ws;
    int ph_lo, ph_hi;
};
enum { I_XP = 0, I_XS, I_CAK, I_CAV, I_SB, I_CCK, I_CCV, I_C, I_CCTX, I_WMOD, I_BMOD, I_GNORM, I_WIN, I_GQK, I_GOUTA, I_CONVW, I_ALOG, I_DTB,
       I_GONB, I_RPB, I_GOUTC, I_WOUT, I_WGU, I_WDN };

__device__ __forceinline__ int otid() { int t = threadIdx.x; asm volatile("" : "+v"(t)); return t; }
__device__ __forceinline__ int obid() { int b = blockIdx.x; asm volatile("" : "+s"(b)); return b; }
__device__ __forceinline__ bf16 f2bf(float f) { unsigned u = __float_as_uint(f); u += 0x7fffu + ((u >> 16) & 1u); return (bf16)(u >> 16); }
__device__ __forceinline__ float bf2f(bf16 h) { return __uint_as_float(((unsigned)h) << 16); }
__device__ __forceinline__ unsigned pk2(float lo, float hi) { return (unsigned)f2bf(lo) | ((unsigned)f2bf(hi) << 16); }
__device__ __forceinline__ float wave_sum(float v) {
#pragma unroll
    for (int o = 32; o >= 1; o >>= 1) v += __shfl_xor(v, o);
    return v;
}
__device__ __forceinline__ float silu_f(float x) { return x / (1.f + __expf(-x)); }
__device__ __forceinline__ float sigmoid_f(float x) { return 1.f / (1.f + __expf(-x)); }
__device__ __forceinline__ float softplus_f(float x) { return fmaxf(x, 0.f) + log1pf(__expf(-fabsf(x))); }
__device__ __forceinline__ int modvec(int t) { return t < TCTX ? 0 : 1 + ((t - TCTX) >> 11); }

__device__ __forceinline__ void phase_prologue(const Params& p, char* lds) {
    const int tid = otid();
    float* mod = (float*)(p.ws + WS_MOD);
    float* sv = (float*)lds;
    float* red = sv + 3 * 1024;
    for (int i = tid; i < 3 * 1024; i += NTHR) {
        const int v = i >> 10, k = i & 1023;
        const float c = (v == 0) ? p.in[I_CCTX][k] : p.in[I_C][(v - 1) * 1024 + k];
        sv[i] = silu_f(c);
    }
    __syncthreads();
    for (int u = obid(); u < NL * 96; u += gridDim.x) {
        const int l = u / 96, c0 = (u % 96) * 64;
        const int cg4 = tid & 15, kg = tid >> 4;
        const float* w = p.in[I_WMOD] + (size_t)l * 1024 * 6144 + c0 + cg4 * 4;
        float acc[3][4];
#pragma unroll
        for (int v = 0; v < 3; ++v)
#pragma unroll
            for (int e = 0; e < 4; ++e) acc[v][e] = 0.f;
#pragma unroll 8
        for (int kk = 0; kk < 32; ++kk) {
            const int k = kg * 32 + kk;
            const f32x4 wv = *(const f32x4*)(w + (size_t)k * 6144);
#pragma unroll
            for (int v = 0; v < 3; ++v) {
                const float s = sv[v * 1024 + k];
                acc[v][0] += s * wv[0]; acc[v][1] += s * wv[1]; acc[v][2] += s * wv[2]; acc[v][3] += s * wv[3];
            }
        }
#pragma unroll
        for (int v = 0; v < 3; ++v)
#pragma unroll
            for (int e = 0; e < 4; ++e) red[(kg * 16 + cg4) * 12 + v * 4 + e] = acc[v][e];
        __syncthreads();
        if (tid < 192) {
            const int v = tid >> 6, c = tid & 63;
            float s = 0.f;
            for (int g = 0; g < 32; ++g) s += red[(g * 16 + (c >> 2)) * 12 + v * 4 + (c & 3)];
            mod[((size_t)l * 3 + v) * 6144 + c0 + c] = s + p.in[I_BMOD][(size_t)l * 6144 + c0 + c];
        }
        __syncthreads();
    }
    {
        const size_t gt = (size_t)obid() * NTHR + tid, gn = (size_t)gridDim.x * NTHR;
        bf16* cak = (bf16*)(p.ws + WS_CAK); bf16* cav = (bf16*)(p.ws + WS_CAV);
        bf16* cck = (bf16*)(p.ws + WS_CCK); bf16* ccv = (bf16*)(p.ws + WS_CCV);
        for (size_t i = gt; i < (size_t)2 * 4 * 256 * 128; i += gn) { cak[i] = f2bf(p.in[I_CAK][i]); cav[i] = f2bf(p.in[I_CAV][i]); }
        for (size_t i = gt; i < (size_t)2 * 4 * 256 * 384; i += gn) { cck[i] = f2bf(p.in[I_CCK][i]); ccv[i] = f2bf(p.in[I_CCV][i]); }
    }
    if (obid() == 0) {
        float* rc = (float*)(p.ws + WS_ROPE); float* rs = rc + 1024;
        for (int i = tid; i < 1024; i += NTHR) {
            const int pos = i >> 4, f = i & 15;
            const float inv = exp2f(-(float)f * (13.287712379549449f / 16.f));
            const float ang = (float)pos * inv;
            const float rev = ang * 0.15915494309189535f;
            const float fr = rev - rintf(rev);
            const float r = fr * 6.283185307179586f;
            rc[i] = __cosf(r); rs[i] = __sinf(r);
        }
    }
}

__device__ __forceinline__ void wconv_item(const float* W, int K, int N, bf16* WT, int item, int mode, float* scr, int lane) {
    const int nblk = (N + 31) / 32, kb = item / nblk, nb = item % nblk, k0 = 64 * kb, n0 = 32 * nb;
    const int nvalid = min(32, N - n0);
    const int cl = lane & 31;
#pragma unroll 8
    for (int i = 0; i < 32; ++i) {
        const int kk = 2 * i + (lane >> 5);
        scr[kk * 33 + cl] = (cl < nvalid) ? W[(size_t)(k0 + kk) * N + n0 + cl] : 0.f;
    }
    asm volatile("s_waitcnt lgkmcnt(0)" ::: "memory");
    __builtin_amdgcn_wave_barrier();
    int drow0 = n0;
    if (mode == 1) drow0 = (n0 < DFF) ? 64 * (n0 / 32) : 64 * ((n0 - DFF) / 32) + 32;
    const int c = lane & 7;
#pragma unroll
    for (int j = 0; j < 4; ++j) {
        const int n = (lane >> 3) + 8 * j;
        const float* s = scr + (8 * c) * 33 + n;
        uint4 o; o.x = pk2(s[0], s[33]); o.y = pk2(s[66], s[99]); o.z = pk2(s[132], s[165]); o.w = pk2(s[198], s[231]);
        if (n < nvalid) *(uint4*)(WT + (size_t)(drow0 + n) * K + k0 + 8 * c) = o;
    }
    asm volatile("s_waitcnt lgkmcnt(0)" ::: "memory");
    __builtin_amdgcn_wave_barrier();
}

__device__ __forceinline__ void phase_wconv(const Params& p, int l, char* lds) {
    const int lane = otid() & 63, wave = otid() >> 6;
    float* scr = (float*)lds + wave * (64 * 33);
    const int gw = obid() * 8 + wave, ngw = gridDim.x * 8;
    constexpr int I_IN = 16 * 89, I_OUT = 16 * 32, I_GU = 16 * 176, I_DN = 44 * 32;
    for (int it = gw; it < I_IN + I_OUT + I_GU + I_DN; it += ngw) {
        int r = it;
        if (r < I_IN) { wconv_item(p.in[I_WIN] + (size_t)l * D * INW, D, INW, (bf16*)(p.ws + WS_WIN), r, 0, scr, lane); continue; } r -= I_IN;
        if (r < I_OUT) { wconv_item(p.in[I_WOUT] + (size_t)l * D * D, D, D, (bf16*)(p.ws + WS_WOUT), r, 0, scr, lane); continue; } r -= I_OUT;
        if (r < I_GU) { wconv_item(p.in[I_WGU] + (size_t)l * D * GUW, D, GUW, (bf16*)(p.ws + WS_WGU), r, 1, scr, lane); continue; } r -= I_GU;
        wconv_item(p.in[I_WDN] + (size_t)l * DFF * D, DFF, D, (bf16*)(p.ws + WS_WDN), r, 0, scr, lane);
    }
}

__device__ __forceinline__ void phase_rows(const Params& p, int l, int kind  ) {
    const int lane = otid() & 63, wave = otid() >> 6;
    const int gw = obid() * 8 + wave, ngw = gridDim.x * 8;
    const float* mod = (const float*)(p.ws + WS_MOD);
    const float* gnorm = p.in[I_GNORM];
    float* X = p.out + OUT_Y;
    const float* SRC = (const float*)(p.ws + WS_Z);
    bf16* H = (bf16*)(p.ws + WS_HY);
    for (int t = gw; t < T; t += ngw) {
        const int v = modvec(t);
        f32x4 x[4];
        const float* xin;
        bool has_src; const float* gate = nullptr; const float* gsrc = nullptr;
        if (kind == 0) {
            if (l == 0) { xin = (t < TCTX) ? p.in[I_XP] + (size_t)t * D : p.in[I_XS] + (size_t)(t - TCTX) * D; has_src = false; }
            else { xin = X + (size_t)t * D; has_src = true; gate = mod + ((size_t)(l - 1) * 3 + v) * 6144 + 5 * 1024; gsrc = gnorm + ((size_t)(l - 1) * 4 + 3) * D; }
        } else { xin = X + (size_t)t * D; has_src = true; gate = mod + ((size_t)l * 3 + v) * 6144 + 2 * 1024; gsrc = gnorm + ((size_t)l * 4 + 1) * D; }
#pragma unroll
        for (int j = 0; j < 4; ++j) x[j] = *(const f32x4*)(xin + 4 * lane + 256 * j);
        if (has_src) {
            f32x4 s[4]; float ss = 0.f;
#pragma unroll
            for (int j = 0; j < 4; ++j) { s[j] = *(const f32x4*)(SRC + (size_t)t * D + 4 * lane + 256 * j); ss += s[j][0] * s[j][0] + s[j][1] * s[j][1] + s[j][2] * s[j][2] + s[j][3] * s[j][3]; }
            const float rstd = rsqrtf(wave_sum(ss) * (1.f / D) + EPS);
#pragma unroll
            for (int j = 0; j < 4; ++j) {
                const f32x4 gt = *(const f32x4*)(gate + 4 * lane + 256 * j), gs = *(const f32x4*)(gsrc + 4 * lane + 256 * j);
#pragma unroll
                for (int e = 0; e < 4; ++e) x[j][e] += gt[e] * (s[j][e] * rstd * gs[e]);
            }
        }
        if (has_src || l == 0) {
#pragma unroll
            for (int j = 0; j < 4; ++j) *(f32x4*)(X + (size_t)t * D + 4 * lane + 256 * j) = x[j];
        }
        const bool want_h = (kind == 1) || (l < NL);
        if (want_h) {
            const int gi = (kind == 0) ? 0 : 2;
            const float* gn = gnorm + ((size_t)l * 4 + gi) * D;
            const float* sh = mod + ((size_t)l * 3 + v) * 6144 + (kind == 0 ? 0 : 3) * 1024;
            const float* sc = sh + 1024;
            float ss = 0.f;
#pragma unroll
            for (int j = 0; j < 4; ++j) ss += x[j][0] * x[j][0] + x[j][1] * x[j][1] + x[j][2] * x[j][2] + x[j][3] * x[j][3];
            const float rstd = rsqrtf(wave_sum(ss) * (1.f / D) + EPS);
#pragma unroll
            for (int j = 0; j < 4; ++j) {
                const f32x4 g = *(const f32x4*)(gn + 4 * lane + 256 * j), a = *(const f32x4*)(sc + 4 * lane + 256 * j), b = *(const f32x4*)(sh + 4 * lane + 256 * j);
                float h[4];
#pragma unroll
                for (int e = 0; e < 4; ++e) h[e] = (x[j][e] * rstd * g[e]) * (1.f + a[e]) + b[e];
                uint2 o; o.x = pk2(h[0], h[1]); o.y = pk2(h[2], h[3]);
                *(uint2*)(H + (size_t)t * D + 4 * lane + 256 * j) = o;
            }
        }
    }
}

__device__ __forceinline__ void phase_ybuild(const Params& p, int l) {
    const int lane = otid() & 63, wave = otid() >> 6;
    const int gw = obid() * 8 + wave, ngw = gridDim.x * 8;
    const bf16* O = (const bf16*)(p.ws + WS_O);
    const float* OB = (const float*)(p.ws + WS_OB);
    const float* Z = (const float*)(p.ws + WS_Z);
    bf16* Y = (bf16*)(p.ws + WS_HY);
    const float* ga = p.in[I_GOUTA] + (size_t)l * 384; const float* gc = p.in[I_GOUTC] + (size_t)l * 384; const float* gb = p.in[I_GONB] + (size_t)l * 64;
    for (int t = gw; t < T; t += ngw) {
        float a[6], c[6]; float sa = 0.f, sc = 0.f;
#pragma unroll
        for (int j = 0; j < 6; ++j) {
            a[j] = bf2f(O[(size_t)t * 768 + lane + 64 * j]); c[j] = bf2f(O[(size_t)t * 768 + 384 + lane + 64 * j]);
            sa += a[j] * a[j]; sc += c[j] * c[j];
        }
        const float ra = rsqrtf(wave_sum(sa) * (1.f / 384.f) + EPS), rc = rsqrtf(wave_sum(sc) * (1.f / 384.f) + EPS);
#pragma unroll
        for (int j = 0; j < 6; ++j) {
            Y[(size_t)t * D + lane + 64 * j] = f2bf(a[j] * ra * ga[lane + 64 * j]);
            Y[(size_t)t * D + 640 + lane + 64 * j] = f2bf(c[j] * rc * gc[lane + 64 * j]);
        }
#pragma unroll
        for (int hh = 0; hh < 4; ++hh) {
            const float o = OB[(size_t)t * 256 + hh * 64 + lane] + OB[(size_t)T * 256 + (size_t)t * 256 + hh * 64 + lane];
            const float r = rsqrtf(wave_sum(o * o) * (1.f / 64.f) + EPS);
            const float g = silu_f(Z[(size_t)t * ZW + ZC_BG + hh * 64 + lane]);
            Y[(size_t)t * D + 384 + hh * 64 + lane] = f2bf(o * r * gb[lane] * g);
        }
    }
}

template <int BM, int BN, int WM, int WN, int EPI>
__device__ __forceinline__ void phase_gemm(const Params& p, int l, const bf16* A, int lda, const bf16* Bt, int K, int tiles_n, char* lds) {
    constexpr int WTM = BM / WM, WTN = BN / WN, TM = WTM / 16, TN = WTN / 16;
    constexpr int LS = 72;
    constexpr int AP = BM * 8 / NTHR, BP = BN * 8 / NTHR;
    static_assert(WM * WN == 8, "8 waves");
    const int tid = otid(), lane = tid & 63, wave = tid >> 6;
    const int wm = wave / WN, wn = wave % WN;
    const int fr = lane & 15, fq = lane >> 4;
    constexpr int STG = (BM + BN) * LS;
    bf16* const sbase = (bf16*)lds;
    static_assert(2 * (BM + BN) * LS * 2 <= LDS_BYTES, "lds");
    const int tiles_m = T / BM, nunits = tiles_m * tiles_n, nk = K / 64;
    for (int u = obid(); u < nunits; u += gridDim.x) {
        const int tn_i = u / tiles_m, tm_i = u % tiles_m;
        const int m0 = tm_i * BM, n0 = tn_i * BN;
        f32x4 acc[TM][TN];
#pragma unroll
        for (int i = 0; i < TM; ++i)
#pragma unroll
            for (int j = 0; j < TN; ++j) acc[i][j] = (f32x4){0.f, 0.f, 0.f, 0.f};
        uint4 ra[AP], rb[BP];
        const bf16* Ab = A + (size_t)m0 * lda; const bf16* Bb = Bt + (size_t)n0 * K;
#pragma unroll
        for (int q = 0; q < AP; ++q) { const int c = tid + NTHR * q; ra[q] = *(const uint4*)(Ab + (size_t)(c >> 3) * lda + (c & 7) * 8); }
#pragma unroll
        for (int q = 0; q < BP; ++q) { const int c = tid + NTHR * q; rb[q] = *(const uint4*)(Bb + (size_t)(c >> 3) * K + (c & 7) * 8); }
#pragma unroll
        for (int q = 0; q < AP; ++q) { const int c = tid + NTHR * q; *(uint4*)(sbase + (c >> 3) * LS + (c & 7) * 8) = ra[q]; }
#pragma unroll
        for (int q = 0; q < BP; ++q) { const int c = tid + NTHR * q; *(uint4*)(sbase + BM * LS + (c >> 3) * LS + (c & 7) * 8) = rb[q]; }
        __syncthreads();
        for (int kt = 0; kt < nk; ++kt) {
            const int cur = kt & 1;
            if (kt + 1 < nk) {
                const int k0 = (kt + 1) * 64;
#pragma unroll
                for (int q = 0; q < AP; ++q) { const int c = tid + NTHR * q; ra[q] = *(const uint4*)(Ab + (size_t)(c >> 3) * lda + k0 + (c & 7) * 8); }
#pragma unroll
                for (int q = 0; q < BP; ++q) { const int c = tid + NTHR * q; rb[q] = *(const uint4*)(Bb + (size_t)(c >> 3) * K + k0 + (c & 7) * 8); }
            }
            const bf16* sa = sbase + cur * STG + (wm * WTM + fr) * LS + fq * 8;
            const bf16* sb = sbase + cur * STG + BM * LS + (wn * WTN + fr) * LS + fq * 8;
#pragma unroll
            for (int kk = 0; kk < 2; ++kk) {
                bf16x8 af[TM], bfr[TN];
#pragma unroll
                for (int i = 0; i < TM; ++i) af[i] = *(const bf16x8*)(sa + i * 16 * LS + kk * 32);
#pragma unroll
                for (int j = 0; j < TN; ++j) bfr[j] = *(const bf16x8*)(sb + j * 16 * LS + kk * 32);
#pragma unroll
                for (int i = 0; i < TM; ++i)
#pragma unroll
                    for (int j = 0; j < TN; ++j) acc[i][j] = __builtin_amdgcn_mfma_f32_16x16x32_bf16(bfr[j], af[i], acc[i][j], 0, 0, 0);
            }
            if (kt + 1 < nk) {
#pragma unroll
                for (int q = 0; q < AP; ++q) { const int c = tid + NTHR * q; *(uint4*)(sbase + (cur ^ 1) * STG + (c >> 3) * LS + (c & 7) * 8) = ra[q]; }
#pragma unroll
                for (int q = 0; q < BP; ++q) { const int c = tid + NTHR * q; *(uint4*)(sbase + (cur ^ 1) * STG + BM * LS + (c >> 3) * LS + (c & 7) * 8) = rb[q]; }
            }
            __syncthreads();
        }
#pragma unroll
        for (int i = 0; i < TM; ++i) {
            const int row = m0 + wm * WTM + 16 * i + fr;
            if constexpr (EPI == 0) {
                float* Z = (float*)(p.ws + WS_Z); bf16* CQ = (bf16*)(p.ws + WS_CQKV);
#pragma unroll
                for (int j = 0; j < TN; ++j) {
                    const int col = n0 + wn * WTN + 16 * j + 4 * fq;
                    const f32x4 v = acc[i][j];
                    if (col < ZW) { *(f32x4*)(Z + (size_t)row * ZW + col) = v; }
                    else if (col < INW) {
                        uint2 o; o.x = pk2(v[0], v[1]); o.y = pk2(v[2], v[3]);
                        *(uint2*)(CQ + (size_t)row * CW + (col - PC_CQ)) = o;
                        if (row < TCTX && col >= PC_CK) {
                            const int b = row >> 8, s = row & 255;
                            float* dst = (col < PC_CV) ? p.out + OUT_CK + ((size_t)(b * NL + l) * SEQ + s) * 384 + (col - PC_CK)
                                                       : p.out + OUT_CV + ((size_t)(b * NL + l) * SEQ + s) * 384 + (col - PC_CV);
                            *(f32x4*)dst = v;
                        }
                    }
                }
            } else if constexpr (EPI == 1) {
                float* C = (float*)(p.ws + WS_Z);
#pragma unroll
                for (int j = 0; j < TN; ++j) { const int col = n0 + wn * WTN + 16 * j + 4 * fq; *(f32x4*)(C + (size_t)row * D + col) = acc[i][j]; }
            } else {
                static_assert(EPI != 2 || (WTN == 64), "gate/up interleave needs 64-wide wave tiles");
                bf16* ACT = (bf16*)(p.ws + WS_D1);
                const int jb = (n0 + wn * WTN) / 64;
#pragma unroll
                for (int j = 0; j < 2; ++j) {
                    const f32x4 g = acc[i][j], uu = acc[i][j + 2];
                    float h[4];
#pragma unroll
                    for (int e = 0; e < 4; ++e) h[e] = silu_f(g[e]) * uu[e];
                    uint2 o; o.x = pk2(h[0], h[1]); o.y = pk2(h[2], h[3]);
                    *(uint2*)(ACT + (size_t)row * DFF + jb * 32 + 16 * j + 4 * fq) = o;
                }
            }
        }
    }
}

__device__ __forceinline__ void p_tokens(const Params& p, int l) {
    const int lane = otid() & 63, wave = otid() >> 6;
    const int gw = obid() * 8 + wave, ngw = gridDim.x * 8;
    const float* Z = (const float*)(p.ws + WS_Z);
    bf16* QKA = (bf16*)(p.ws + WS_QKA);
    const float* rc = (const float*)(p.ws + WS_ROPE); const float* rs = rc + 1024;
    const float gq = p.in[I_GQK][(size_t)l * 128 + lane], gk = p.in[I_GQK][(size_t)l * 128 + 64 + lane];
    for (int t = gw; t < T; t += ngw) {
        const bool lat = t >= TCTX;
        float cs = 1.f, sn = 0.f;
        if (lat) {
            const int pos = (t - TCTX) & 2047, row = pos >> 6, colp = pos & 63, i = lane & 31;
            const int idx = (i < 16) ? row * 16 + i : colp * 16 + (i - 16);
            cs = rc[idx]; sn = rs[idx];
        }
#pragma unroll
        for (int slot = 0; slot < 10; ++slot) {
            const float z = Z[(size_t)t * ZW + slot * 64 + lane];
            float y = z;
            if (slot < 8) {
                const float r = rsqrtf(wave_sum(z * z) * (1.f / 64.f) + EPS);
                y = z * r * (slot < 6 ? gq : gk);
                if (!lat) {
                    if (slot >= 6) { const int b = t >> 8, s = t & 255; p.out[OUT_AK + ((size_t)(b * NL + l) * SEQ + s) * 128 + (slot - 6) * 64 + lane] = y; }
                } else {
                    const float pr = __shfl_xor(y, 32);
                    y = (lane < 32) ? y * cs - pr * sn : pr * sn + y * cs;
                }
            } else if (!lat) {
                const int b = t >> 8, s = t & 255; p.out[OUT_AV + ((size_t)(b * NL + l) * SEQ + s) * 128 + (slot - 8) * 64 + lane] = z;
            }
            QKA[(size_t)t * 640 + slot * 64 + lane] = f2bf(y);
        }
    }
}

struct ChunkId { int lat, b, h, dir, n, L, tok0; };
__device__ __forceinline__ ChunkId decode_cd(int cd) {
    ChunkId c;
    if (cd < 1024) { c.lat = 0; const int chain = cd >> 2; c.n = cd & 3; c.dir = chain & 1; c.h = (chain >> 1) & 3; c.b = chain >> 3; c.L = SEQ; c.tok0 = c.b * SEQ; }
    else { const int r = cd - 1024; c.lat = 1; const int chain = r >> 5; c.n = r & 31; c.dir = chain & 1; c.h = (chain >> 1) & 3; c.b = chain >> 3; c.L = LSEQ; c.tok0 = TCTX + c.b * LSEQ; }
    return c;
}

__device__ __forceinline__ void d1_unit(const Params& p, int l, int cd, char* lds) {
    const int tid = otid();
    const ChunkId c = decode_cd(cd);
    const float* Z = (const float*)(p.ws + WS_Z);
    float* sq = (float*)lds;
    float* sk = sq + 64 * 65;
    float* svv = sk + 64 * 65;
    float* sL = svv + 64 * 65;
    float* rhs = sL + 64 * 65;
    float* sg = rhs + 64 * 129;
    float* sbeta = sg + 64;
    float* snrm = sbeta + 64;
    float* d1 = (float*)(p.ws + WS_D1) + (size_t)cd * 5 * 4096;
    const float* cw = p.in[I_CONVW] + (size_t)l * 3 * 768;
    for (int e = tid; e < 64 * 192; e += NTHR) {
        const int i = e / 192, ch = e % 192, part = ch >> 6, d = ch & 63;
        const int pos = c.n * 64 + i, s = c.dir ? (c.L - 1 - pos) : pos;
        const int cc = part * 256 + c.h * 64 + d;
        const float* zr = Z + (size_t)(c.tok0 + s) * ZW + ZC_BQKV + cc;
        const float xm = (s > 0) ? zr[-ZW] : 0.f, x0 = zr[0], xp = (s < c.L - 1) ? zr[ZW] : 0.f;
        const float y = silu_f(xm * cw[cc] + x0 * cw[768 + cc] + xp * cw[1536 + cc]);
        float* dst = (part == 0) ? sq : (part == 1 ? sk : svv);
        dst[i * 65 + d] = y;
    }
    if (tid < 64) {
        const int pos = c.n * 64 + tid, s = c.dir ? (c.L - 1 - pos) : pos;
        const float* zr = Z + (size_t)(c.tok0 + s) * ZW;
        sbeta[tid] = sigmoid_f(zr[ZC_BBETA + c.dir * 4 + c.h]);
        const float al = p.in[I_ALOG][(size_t)l * 8 + c.dir * 4 + c.h], dtb = p.in[I_DTB][(size_t)l * 8 + c.dir * 4 + c.h];
        sg[tid] = -__expf(al) * softplus_f(zr[ZC_BALPHA + c.dir * 4 + c.h] + dtb);
    }
    __syncthreads();
    if (tid < 128) {
        const float* m = (tid < 64) ? sq + tid * 65 : sk + (tid - 64) * 65;
        float ss = 0.f;
#pragma unroll 8
        for (int d = 0; d < 64; ++d) ss += m[d] * m[d];
        snrm[tid] = rsqrtf(ss + EPS) * (tid < 64 ? 0.125f : 1.f);
    } else if (tid == 128) {
        float a = 0.f;
#pragma unroll 4
        for (int i = 0; i < 64; ++i) { a += sg[i]; sg[i] = a; }
    }
    __syncthreads();
    for (int e = tid; e < 64 * 64; e += NTHR) { const int i = e >> 6, d = e & 63; sq[i * 65 + d] *= snrm[i]; sk[i * 65 + d] *= snrm[64 + i]; }
    __syncthreads();
    const float gl = sg[63];
    for (int e = tid; e < 64 * 64; e += NTHR) {
        const int i = e >> 6, j = e & 63;
        float dkk = 0.f, dqk = 0.f;
#pragma unroll 8
        for (int d = 0; d < 64; ++d) { const float kj = sk[j * 65 + d]; dkk += sk[i * 65 + d] * kj; dqk += sq[i * 65 + d] * kj; }
        const float dec = (i >= j) ? __expf(sg[i] - sg[j]) : 0.f;
        sL[i * 65 + j] = (i > j) ? sbeta[i] * dkk * dec : 0.f;
        d1[2 * 4096 + e] = dqk * dec;
        const float egi = __expf(sg[i]);
        rhs[i * 129 + j] = svv[i * 65 + j] * sbeta[i];
        rhs[i * 129 + 64 + j] = sk[i * 65 + j] * sbeta[i] * egi;
        d1[3 * 4096 + e] = sq[i * 65 + j] * egi;
        d1[4 * 4096 + e] = sk[j * 65 + i] * __expf(gl - sg[j]);
    }
    if (tid == 0) ((float*)(p.ws + WS_DEC))[cd] = __expf(gl);
    __syncthreads();
    if (tid < 128) {
#pragma unroll 1
        for (int i = 1; i < 64; ++i) {
            float a = rhs[i * 129 + tid];
#pragma unroll 4
            for (int j = 0; j < i; ++j) a -= sL[i * 65 + j] * rhs[j * 129 + tid];
            rhs[i * 129 + tid] = a;
        }
    }
    __syncthreads();
    for (int e = tid; e < 64 * 64; e += NTHR) { const int i = e >> 6, j = e & 63; d1[e] = rhs[i * 129 + j]; d1[4096 + e] = rhs[i * 129 + 64 + j]; }
    __syncthreads();
}

__device__ __forceinline__ void phase_p(const Params& p, int l, char* lds) {
    p_tokens(p, l);
    for (int cd = obid(); cd < NCD; cd += gridDim.x) d1_unit(p, l, cd, lds);
}

template <int RPT>
__device__ __forceinline__ void dot_rows(const float* mat, int r0, const float* vec, float (&acc)[RPT]) {
#pragma unroll 4
    for (int k4 = 0; k4 < 16; ++k4) {
        const f32x4 b = *(const f32x4*)(vec + 4 * k4);
#pragma unroll
        for (int r = 0; r < RPT; ++r) {
            const f32x4 a = *(const f32x4*)(mat + (r0 + r) * 68 + 4 * k4);
            acc[r] += a[0] * b[0] + a[1] * b[1] + a[2] * b[2] + a[3] * b[3];
        }
    }
}

template <int NC>
__device__ __forceinline__ void d2_unit(const Params& p, int l, int lat, int chain, int slice, char* lds) {
    constexpr int RPT = NC / 8;
    const int tid = otid();
    const int dir = chain & 1, h = (chain >> 1) & 3, b = chain >> 3;
    const int L = lat ? LSEQ : SEQ, nch = L / 64, tok0 = lat ? TCTX + b * LSEQ : b * SEQ;
    const int cd0 = lat ? 1024 + chain * 32 : chain * 4;
    const int c0 = slice * NC;
    float* mw = (float*)lds;
    float* mq = mw + 64 * 68;
    float* ma = mq + 64 * 68;
    float* mk = ma + 64 * 68;
    float* ST = mk + 64 * 68;
    float* VT = ST + NC * 68;
    const int c = tid % NC, ig = tid / NC, r0 = ig * RPT;
    float* OB = (float*)(p.ws + WS_OB) + (size_t)dir * T * 256;
    for (int e = tid; e < 64 * NC; e += NTHR) {
        const int k = e / NC, cc = e % NC;
        ST[cc * 68 + k] = lat ? p.in[I_SB][((((size_t)b * NL + l) * 2 + dir) * 4 + h) * 4096 + k * 64 + c0 + cc] : 0.f;
    }
    for (int n = 0; n < nch; ++n) {
        const float* d1 = (const float*)(p.ws + WS_D1) + (size_t)(cd0 + n) * 5 * 4096;
        const float dec = ((const float*)(p.ws + WS_DEC))[cd0 + n];
        __syncthreads();
        for (int e = tid; e < 1024; e += NTHR) {
            const int r = e >> 4, c4 = (e & 15) * 4;
            *(f32x4*)(mw + r * 68 + c4) = *(const f32x4*)(d1 + 4096 + r * 64 + c4);
            *(f32x4*)(mq + r * 68 + c4) = *(const f32x4*)(d1 + 3 * 4096 + r * 64 + c4);
            *(f32x4*)(ma + r * 68 + c4) = *(const f32x4*)(d1 + 2 * 4096 + r * 64 + c4);
            *(f32x4*)(mk + r * 68 + c4) = *(const f32x4*)(d1 + 4 * 4096 + r * 64 + c4);
        }
        __syncthreads();
        {
            float acc[RPT];
#pragma unroll
            for (int r = 0; r < RPT; ++r) acc[r] = 0.f;
            dot_rows<RPT>(mw, r0, ST + c * 68, acc);
#pragma unroll
            for (int r = 0; r < RPT; ++r) VT[c * 68 + r0 + r] = d1[(r0 + r) * 64 + c0 + c] - acc[r];
        }
        __syncthreads();
        float sn[RPT];
        {
            float acc[RPT];
#pragma unroll
            for (int r = 0; r < RPT; ++r) acc[r] = 0.f;
            dot_rows<RPT>(mq, r0, ST + c * 68, acc);
            dot_rows<RPT>(ma, r0, VT + c * 68, acc);
#pragma unroll
            for (int r = 0; r < RPT; ++r) {
                const int pos = n * 64 + r0 + r, s = dir ? (L - 1 - pos) : pos;
                OB[(size_t)(tok0 + s) * 256 + h * 64 + c0 + c] = acc[r];
            }
#pragma unroll
            for (int r = 0; r < RPT; ++r) sn[r] = 0.f;
            dot_rows<RPT>(mk, r0, VT + c * 68, sn);
#pragma unroll
            for (int r = 0; r < RPT; ++r) sn[r] += ST[c * 68 + r0 + r] * dec;
        }
        __syncthreads();
#pragma unroll
        for (int r = 0; r < RPT; ++r) ST[c * 68 + r0 + r] = sn[r];
    }
    __syncthreads();
    if (!lat) {
        for (int e = tid; e < 64 * NC; e += NTHR) {
            const int k = e / NC, cc = e % NC;
            p.out[OUT_SB + ((((size_t)b * NL + l) * 2 + dir) * 4 + h) * 4096 + k * 64 + c0 + cc] = ST[cc * 68 + k];
        }
    }
    __syncthreads();
}

struct AttnSeg { const bf16* K; const bf16* V; int stride; int nkeys; };

__device__ __forceinline__ void attn_unit(const bf16* Q, int qstride, AttnSeg s0, AttnSeg s1, int mode, int R0, int kr0, const float* rpb_h, bf16* O, int ostride, char* lds) {
    const int tid = otid(), lane = tid & 63, wave = tid >> 6;
    const int qi = lane & 15, g = lane >> 4;
    bf16* Ks = (bf16*)lds;
    bf16* Vt = Ks + 64 * 72;
    float* rp = (float*)(Vt + 64 * 72);
    if (mode == 1) { for (int i = tid; i < 465; i += NTHR) rp[i] = rpb_h[i]; }
    bf16x8 qf[2];
    qf[0] = *(const bf16x8*)(Q + (size_t)(wave * 16 + qi) * qstride + g * 8);
    qf[1] = *(const bf16x8*)(Q + (size_t)(wave * 16 + qi) * qstride + 32 + g * 8);
    float m = -INFINITY, lsum = 0.f;
    f32x4 o[4];
#pragma unroll
    for (int i = 0; i < 4; ++i) o[i] = (f32x4){0.f, 0.f, 0.f, 0.f};
    const int qr = R0 + (wave >> 2), qc = (wave & 3) * 16 + qi;
    const int rs = min(max(qr - 4, 0), 24), cst = min(max(qc - 8, 0), 48);
    for (int seg = 0; seg < 2; ++seg) {
        AttnSeg sg;
        sg.K = seg ? s1.K : s0.K; sg.V = seg ? s1.V : s0.V; sg.stride = seg ? s1.stride : s0.stride; sg.nkeys = seg ? s1.nkeys : s0.nkeys;
        for (int k0 = 0; k0 < sg.nkeys; k0 += 64) {
            __syncthreads();
            {
                const int key = tid >> 3, cc = tid & 7;
                const uint4 kv = *(const uint4*)(sg.K + (size_t)(k0 + key) * sg.stride + cc * 8);
                const uint4 vv = *(const uint4*)(sg.V + (size_t)(k0 + key) * sg.stride + cc * 8);
                *(uint4*)(Ks + key * 72 + cc * 8) = kv;
                const unsigned w[4] = {vv.x, vv.y, vv.z, vv.w};
#pragma unroll
                for (int e = 0; e < 4; ++e) { Vt[(cc * 8 + 2 * e) * 72 + key] = (bf16)(w[e] & 0xffffu); Vt[(cc * 8 + 2 * e + 1) * 72 + key] = (bf16)(w[e] >> 16); }
            }
            __syncthreads();
            const bool nb = (mode == 1 && seg == 0);
            const int kr = kr0 + (k0 >> 6);
            if (nb && (kr < rs || kr >= rs + 8)) continue;
            f32x4 s[4];
#pragma unroll
            for (int kt = 0; kt < 4; ++kt) {
                s[kt] = (f32x4){0.f, 0.f, 0.f, 0.f};
#pragma unroll
                for (int kk = 0; kk < 2; ++kk) {
                    const bf16x8 kf = *(const bf16x8*)(Ks + (kt * 16 + qi) * 72 + kk * 32 + g * 8);
                    s[kt] = __builtin_amdgcn_mfma_f32_16x16x32_bf16(kf, qf[kk], s[kt], 0, 0, 0);
                }
            }
            float tmax = -INFINITY;
#pragma unroll
            for (int kt = 0; kt < 4; ++kt)
#pragma unroll
                for (int i = 0; i < 4; ++i) {
                    float v = s[kt][i] * 0.125f;
                    if (nb) {
                        const int kc = kt * 16 + 4 * g + i;
                        const int dc = min(max(kc - qc + 15, 0), 30);
                        v += rp[(kr - qr + 7) * 31 + dc];
                        if (kc < cst || kc >= cst + 16) v = -INFINITY;
                    }
                    s[kt][i] = v; tmax = fmaxf(tmax, v);
                }
            tmax = fmaxf(tmax, __shfl_xor(tmax, 16)); tmax = fmaxf(tmax, __shfl_xor(tmax, 32));
            const float mn = fmaxf(m, tmax);
            const float mu = (mn == -INFINITY) ? 0.f : mn;
            const float alpha = __expf(m - mu);
            m = mn;
            float ps = 0.f;
#pragma unroll
            for (int kt = 0; kt < 4; ++kt)
#pragma unroll
                for (int i = 0; i < 4; ++i) { const float pv = __expf(s[kt][i] - mu); s[kt][i] = pv; ps += pv; }
            lsum = lsum * alpha + ps;
#pragma unroll
            for (int dt = 0; dt < 4; ++dt) { o[dt][0] *= alpha; o[dt][1] *= alpha; o[dt][2] *= alpha; o[dt][3] *= alpha; }
#pragma unroll
            for (int pp = 0; pp < 2; ++pp) {
                union { bf16x8 v; unsigned u[4]; } pf;
                pf.u[0] = pk2(s[2 * pp][0], s[2 * pp][1]); pf.u[1] = pk2(s[2 * pp][2], s[2 * pp][3]);
                pf.u[2] = pk2(s[2 * pp + 1][0], s[2 * pp + 1][1]); pf.u[3] = pk2(s[2 * pp + 1][2], s[2 * pp + 1][3]);
#pragma unroll
                for (int dt = 0; dt < 4; ++dt) {
                    union { bf16x8 v; uint2 h[2]; } vf;
                    vf.h[0] = *(const uint2*)(Vt + (dt * 16 + qi) * 72 + (2 * pp) * 16 + 4 * g);
                    vf.h[1] = *(const uint2*)(Vt + (dt * 16 + qi) * 72 + (2 * pp + 1) * 16 + 4 * g);
                    o[dt] = __builtin_amdgcn_mfma_f32_16x16x32_bf16(vf.v, pf.v, o[dt], 0, 0, 0);
                }
            }
        }
    }
    lsum += __shfl_xor(lsum, 16); lsum += __shfl_xor(lsum, 32);
    const float inv = 1.f / lsum;
#pragma unroll
    for (int dt = 0; dt < 4; ++dt) {
        uint2 w; w.x = pk2(o[dt][0] * inv, o[dt][1] * inv); w.y = pk2(o[dt][2] * inv, o[dt][3] * inv);
        *(uint2*)(O + (size_t)(wave * 16 + qi) * ostride + dt * 16 + 4 * g) = w;
    }
    __syncthreads();
}

constexpr int MIX_BLAT = 64, MIX_ALAT = 192, MIX_CLAT = 192, MIX_BCTX = 256, MIX_ACTX = 384, MIX_CCTX = 384;
constexpr int MIX_TOTAL = MIX_BLAT + MIX_ALAT + MIX_CLAT + MIX_BCTX + MIX_ACTX + MIX_CCTX;

__device__ __forceinline__ void phase_mix(const Params& p, int l, char* lds) {
    unsigned* ctr = (unsigned*)(p.ws + WS_CTR) + l * 64;
    int* su = (int*)(lds + LDS_BYTES - 16);
    const bf16* QKA = (const bf16*)(p.ws + WS_QKA);
    const bf16* CQ = (const bf16*)(p.ws + WS_CQKV);
    bf16* O = (bf16*)(p.ws + WS_O);
    for (;;) {
        __syncthreads();
        if (otid() == 0) *su = (int)atomicAdd(ctr, 1u);
        __syncthreads();
        int u = *su;
        if (u >= MIX_TOTAL) break;
        if (u < MIX_BLAT) { d2_unit<16>(p, l, 1, u >> 2, u & 3, lds); continue; } u -= MIX_BLAT;
        if (u >= MIX_ALAT + MIX_CLAT && u < MIX_ALAT + MIX_CLAT + MIX_BCTX) { d2_unit<64>(p, l, 0, u - MIX_ALAT - MIX_CLAT, 0, lds); continue; }
        int kind;
        if (u < MIX_ALAT) kind = 0; else if (u < MIX_ALAT + MIX_CLAT) { kind = 1; u -= MIX_ALAT; }
        else { u -= MIX_ALAT + MIX_CLAT + MIX_BCTX; if (u < MIX_ACTX) kind = 2; else { kind = 3; u -= MIX_ACTX; } }
        const bool lat = kind < 2, isA = (kind & 1) == 0;
        const int b = lat ? u / 96 : u / 12, h = lat ? (u % 96) / 16 : (u % 12) / 2, qt = lat ? u % 16 : u % 2;
        const int t0 = lat ? TCTX + b * LSEQ : b * SEQ;
        const int kvh = h / 3;
        int R0 = 0, lo = 0;
        AttnSeg s0, s1;
        const bf16* Qp; int qstride; bf16* Op;
        if (isA) {
            s0.K = QKA + (size_t)t0 * 640 + 384 + kvh * 64; s0.V = QKA + (size_t)t0 * 640 + 512 + kvh * 64; s0.stride = 640; s0.nkeys = lat ? LSEQ : SEQ;
            s1.K = (const bf16*)(p.ws + WS_CAK) + ((size_t)(b * NL + l) * 256) * 128 + kvh * 64; s1.V = (const bf16*)(p.ws + WS_CAV) + ((size_t)(b * NL + l) * 256) * 128 + kvh * 64; s1.stride = 128;
            Qp = QKA + (size_t)(t0 + qt * 128) * 640 + h * 64; qstride = 640; Op = O + (size_t)(t0 + qt * 128) * 768 + h * 64;
        } else {
            int hi = 4;
            if (lat) { R0 = 2 * qt; lo = min(max(R0 - 4, 0), 24); hi = min(max(R0 + 1 - 4, 0), 24) + 8; }
            s0.K = CQ + (size_t)(t0 + lo * 64) * CW + 384 + h * 64; s0.V = CQ + (size_t)(t0 + lo * 64) * CW + 768 + h * 64; s0.stride = CW; s0.nkeys = (hi - lo) * 64;
            s1.K = (const bf16*)(p.ws + WS_CCK) + ((size_t)(b * NL + l) * 256) * 384 + h * 64; s1.V = (const bf16*)(p.ws + WS_CCV) + ((size_t)(b * NL + l) * 256) * 384 + h * 64; s1.stride = 384;
            Qp = CQ + (size_t)(t0 + qt * 128) * CW + h * 64; qstride = CW; Op = O + (size_t)(t0 + qt * 128) * 768 + 384 + h * 64;
        }
        s1.nkeys = lat ? 256 : 0;
        attn_unit(Qp, qstride, s0, s1, kind == 1 ? 1 : 0, R0, lo, p.in[I_RPB] + ((size_t)l * 6 + h) * 465, Op, 768, lds);
    }
}

constexpr int PH_PER_LAYER = 9;
constexpr int N_PHASES = 1 + PH_PER_LAYER * DBG_LAYERS + 1;

__global__ void __launch_bounds__(NTHR) mega_kernel(Params p) {
    extern __shared__ __attribute__((aligned(16))) char lds[];
    cg::grid_group grid = cg::this_grid();
    for (int ph = p.ph_lo; ph < p.ph_hi; ++ph) {
        if (ph > p.ph_lo) grid.sync();
        if (ph == 0) { phase_prologue(p, lds); continue; }
        const bool last = (ph == N_PHASES - 1);
        const int l = last ? DBG_LAYERS : (ph - 1) / PH_PER_LAYER, s = last ? 9 : (ph - 1) % PH_PER_LAYER;
        if (s == 0) phase_wconv(p, l, lds);
        if (s == 0 || s == 6 || s == 9) phase_rows(p, l, s == 6 ? 1 : 0);
        else if (s == 1) phase_gemm<256, 128, 4, 2, 0>(p, l, (const bf16*)(p.ws + WS_HY), D, (const bf16*)(p.ws + WS_WIN), D, INWP / 128, lds);
        else if (s == 2) phase_p(p, l, lds);
        else if (s == 3) phase_mix(p, l, lds);
        else if (s == 4) phase_ybuild(p, l);
        else if (s == 7) phase_gemm<256, 128, 4, 2, 2>(p, l, (const bf16*)(p.ws + WS_HY), D, (const bf16*)(p.ws + WS_WGU), D, GUW / 128, lds);
        else {
            const bool dn = (s == 8);
            phase_gemm<128, 128, 2, 4, 1>(p, l, (const bf16*)(p.ws + (dn ? WS_D1 : WS_HY)), dn ? DFF : D, (const bf16*)(p.ws + (dn ? WS_WDN : WS_WOUT)), dn ? DFF : D, D / 128, lds);
        }
    }
}

extern "C" void kernel_launch(void* const* d_in, const int* in_sizes, int n_in, void* d_out, int out_size, void* d_ws, size_t ws_size, hipStream_t stream) {
    static int grid = 0;
    if (grid == 0) {
        if (n_in != 24 || ws_size < WS_END) { fprintf(stderr, "kernel_launch: unexpected n_in %d or ws_size %zu (need %zu)\n", n_in, ws_size, (size_t)WS_END); grid = -1; return; }
        int dev = 0, cus = 0, per_cu = 0;
        hipGetDevice(&dev);
        hipDeviceGetAttribute(&cus, hipDeviceAttributeMultiprocessorCount, dev);
        hipFuncSetAttribute((const void*)mega_kernel, hipFuncAttributeMaxDynamicSharedMemorySize, LDS_BYTES);
        hipOccupancyMaxActiveBlocksPerMultiprocessor(&per_cu, (const void*)mega_kernel, NTHR, LDS_BYTES);
        if (per_cu < 1) { fprintf(stderr, "kernel_launch: occupancy query says %d blocks per CU\n", per_cu); grid = -1; return; }
        grid = cus;
    }
    if (grid < 0) return;
    hipMemsetAsync((char*)d_ws + WS_CTR, 0, 4096, stream);
    Params p{};
    for (int i = 0; i < 24; ++i) p.in[i] = (const float*)d_in[i];
    p.out = (float*)d_out; p.ws = (unsigned char*)d_ws; p.ph_lo = 0; p.ph_hi = N_PHASES;
    void* args[] = {&p};
    hipError_t e = hipLaunchCooperativeKernel((const void*)mega_kernel, dim3(grid), dim3(NTHR), args, LDS_BYTES, stream);
    if (e != hipSuccess) fprintf(stderr, "cooperative launch failed: %s (grid %d)\n", hipGetErrorString(e), grid);
}
```

```cpp
#include <hip/hip_runtime.h>
#include <hip/hip_cooperative_groups.h>
#include <cstdio>
#include <cstdint>
namespace cg = cooperative_groups;

#ifndef DBG_LAYERS
#define DBG_LAYERS 4
#endif

typedef unsigned short bf16;
typedef short bf16x8 __attribute__((ext_vector_type(8)));
typedef float f32x4 __attribute__((ext_vector_type(4)));

constexpr int D = 1024, TCTX = 8192, TLAT = 4096, T = TCTX + TLAT, NL = 4;
constexpr int SEQ = 256, LSEQ = 2048, NB_CTX = 32, NB_LAT = 2;
constexpr int INW = 2832, INWP = 2944, ZW = 1680, CW = 1152, DFF = 2816, GUW = 5632;
constexpr int NTHR = 512;
constexpr float EPS = 1e-6f;

constexpr int ZC_AQ = 0, ZC_AK = 384, ZC_AV = 512, ZC_BQKV = 640, ZC_BG = 1408, ZC_BBETA = 1664, ZC_BALPHA = 1672;
constexpr int PC_CQ = 1680, PC_CK = 2064, PC_CV = 2448;

constexpr size_t OUT_Y = 0;
constexpr size_t OUT_AK = 12582912, OUT_AV = 16777216, OUT_SB = 20971520, OUT_CK = 25165824, OUT_CV = 37748736;

constexpr size_t al256(size_t x) { return (x + 255) & ~(size_t)255; }
constexpr size_t WS_CTR = 0;
constexpr size_t WS_BAR = 4096;
constexpr size_t WS_ZERO_BYTES = 4096 + 16384;
constexpr size_t WS_MOD = WS_ZERO_BYTES;
constexpr size_t WS_ROPE = al256(WS_MOD + (size_t)NL * 3 * 6144 * 4);
constexpr size_t WS_CAK = al256(WS_ROPE + 2 * 64 * 16 * 4);
constexpr size_t WS_CAV = WS_CAK + (size_t)2 * 4 * 256 * 128 * 2;
constexpr size_t WS_CCK = WS_CAV + (size_t)2 * 4 * 256 * 128 * 2;
constexpr size_t WS_CCV = WS_CCK + (size_t)2 * 4 * 256 * 384 * 2;
constexpr size_t WS_WIN = al256(WS_CCV + (size_t)2 * 4 * 256 * 384 * 2);
constexpr size_t WS_WOUT = WS_WIN + (size_t)INWP * D * 2;
constexpr size_t WS_WGU = WS_WOUT + (size_t)D * D * 2;
constexpr size_t WS_WDN = WS_WGU + (size_t)GUW * D * 2;
constexpr size_t WS_HY = al256(WS_WDN + (size_t)D * DFF * 2);
constexpr size_t WS_Z = WS_HY + (size_t)T * D * 2;
constexpr size_t WS_CQKV = WS_Z + (size_t)T * ZW * 4;
constexpr size_t WS_QKA = WS_CQKV + (size_t)T * CW * 2;
constexpr size_t WS_D1 = WS_QKA + (size_t)T * 640 * 2;
constexpr int NCD = 1536;
constexpr size_t WS_DEC = WS_D1 + (size_t)NCD * 5 * 4096 * 4;
constexpr size_t WS_OB = al256(WS_DEC + NCD * 4);
constexpr size_t WS_O = WS_OB + (size_t)2 * T * 256 * 4;
constexpr size_t WS_END = WS_O + (size_t)T * 768 * 2;
static_assert((size_t)T * DFF * 2 <= (size_t)NCD * 5 * 4096 * 4, "ACT aliases D1");
static_assert((size_t)T * D * 4 <= (size_t)T * ZW * 4, "M/F alias Z");

constexpr int LDS_BYTES = 122880;

struct Params {
    const float* in[24];
    float* out;
    unsigned char* ws;
    int ph_lo, ph_hi;
};
enum { I_XP = 0, I_XS, I_CAK, I_CAV, I_SB, I_CCK, I_CCV, I_C, I_CCTX, I_WMOD, I_BMOD, I_GNORM, I_WIN, I_GQK, I_GOUTA, I_CONVW, I_ALOG, I_DTB,
       I_GONB, I_RPB, I_GOUTC, I_WOUT, I_WGU, I_WDN };

__device__ __forceinline__ int otid() { int t = threadIdx.x; asm volatile("" : "+v"(t)); return t; }
__device__ __forceinline__ int obid() { int b = blockIdx.x; asm volatile("" : "+s"(b)); return b; }
__device__ __forceinline__ bf16 f2bf(float f) { unsigned u = __float_as_uint(f); u += 0x7fffu + ((u >> 16) & 1u); return (bf16)(u >> 16); }
__device__ __forceinline__ float bf2f(bf16 h) { return __uint_as_float(((unsigned)h) << 16); }
__device__ __forceinline__ unsigned pk2(float lo, float hi) { return (unsigned)f2bf(lo) | ((unsigned)f2bf(hi) << 16); }
__device__ __forceinline__ float wave_sum(float v) {
#pragma unroll
    for (int o = 32; o >= 1; o >>= 1) v += __shfl_xor(v, o);
    return v;
}
__device__ __forceinline__ float silu_f(float x) { return x / (1.f + __expf(-x)); }
__device__ __forceinline__ float sigmoid_f(float x) { return 1.f / (1.f + __expf(-x)); }
__device__ __forceinline__ float softplus_f(float x) { return fmaxf(x, 0.f) + log1pf(__expf(-fabsf(x))); }
__device__ __forceinline__ int modvec(int t) { return t < TCTX ? 0 : 1 + ((t - TCTX) >> 11); }

__device__ __forceinline__ void phase_prologue(const Params& p, char* lds) {
    const int tid = otid();
    float* mod = (float*)(p.ws + WS_MOD);
    float* sv = (float*)lds;
    float* red = sv + 3 * 1024;
    for (int i = tid; i < 3 * 1024; i += NTHR) {
        const int v = i >> 10, k = i & 1023;
        const float c = (v == 0) ? p.in[I_CCTX][k] : p.in[I_C][(v - 1) * 1024 + k];
        sv[i] = silu_f(c);
    }
    __syncthreads();
    for (int u = obid(); u < NL * 96; u += gridDim.x) {
        const int l = u / 96, c0 = (u % 96) * 64;
        const int cg4 = tid & 15, kg = tid >> 4;
        const float* w = p.in[I_WMOD] + (size_t)l * 1024 * 6144 + c0 + cg4 * 4;
        float acc[3][4];
#pragma unroll
        for (int v = 0; v < 3; ++v)
#pragma unroll
            for (int e = 0; e < 4; ++e) acc[v][e] = 0.f;
#pragma unroll 8
        for (int kk = 0; kk < 32; ++kk) {
            const int k = kg * 32 + kk;
            const f32x4 wv = *(const f32x4*)(w + (size_t)k * 6144);
#pragma unroll
            for (int v = 0; v < 3; ++v) {
                const float s = sv[v * 1024 + k];
                acc[v][0] += s * wv[0]; acc[v][1] += s * wv[1]; acc[v][2] += s * wv[2]; acc[v][3] += s * wv[3];
            }
        }
#pragma unroll
        for (int v = 0; v < 3; ++v)
#pragma unroll
            for (int e = 0; e < 4; ++e) red[(kg * 16 + cg4) * 12 + v * 4 + e] = acc[v][e];
        __syncthreads();
        if (tid < 192) {
            const int v = tid >> 6, c = tid & 63;
            float s = 0.f;
            for (int g = 0; g < 32; ++g) s += red[(g * 16 + (c >> 2)) * 12 + v * 4 + (c & 3)];
            mod[((size_t)l * 3 + v) * 6144 + c0 + c] = s + p.in[I_BMOD][(size_t)l * 6144 + c0 + c];
        }
        __syncthreads();
    }
    {
        const size_t gt = (size_t)obid() * NTHR + tid, gn = (size_t)gridDim.x * NTHR;
        bf16* cak = (bf16*)(p.ws + WS_CAK); bf16* cav = (bf16*)(p.ws + WS_CAV);
        bf16* cck = (bf16*)(p.ws + WS_CCK); bf16* ccv = (bf16*)(p.ws + WS_CCV);
        for (size_t i = gt; i < (size_t)2 * 4 * 256 * 128; i += gn) { cak[i] = f2bf(p.in[I_CAK][i]); cav[i] = f2bf(p.in[I_CAV][i]); }
        for (size_t i = gt; i < (size_t)2 * 4 * 256 * 384; i += gn) { cck[i] = f2bf(p.in[I_CCK][i]); ccv[i] = f2bf(p.in[I_CCV][i]); }
    }
    if (obid() == 0) {
        float* rc = (float*)(p.ws + WS_ROPE); float* rs = rc + 1024;
        for (int i = tid; i < 1024; i += NTHR) {
            const int pos = i >> 4, f = i & 15;
            const float inv = exp2f(-(float)f * (13.287712379549449f / 16.f));
            const float ang = (float)pos * inv;
            const float rev = ang * 0.15915494309189535f;
            const float fr = rev - rintf(rev);
            const float r = fr * 6.283185307179586f;
            rc[i] = __cosf(r); rs[i] = __sinf(r);
        }
    }
}

__device__ __forceinline__ void wconv_item(const float* W, int K, int N, bf16* WT, int item, int mode, float* scr, int lane) {
    const int nblk = (N + 31) / 32, kb = item / nblk, nb = item % nblk, k0 = 64 * kb, n0 = 32 * nb;
    const int nvalid = min(32, N - n0);
    const int cl = lane & 31;
#pragma unroll 8
    for (int i = 0; i < 32; ++i) {
        const int kk = 2 * i + (lane >> 5);
        scr[kk * 33 + cl] = (cl < nvalid) ? W[(size_t)(k0 + kk) * N + n0 + cl] : 0.f;
    }
    asm volatile("s_waitcnt lgkmcnt(0)" ::: "memory");
    __builtin_amdgcn_wave_barrier();
    int drow0 = n0;
    if (mode == 1) drow0 = (n0 < DFF) ? 64 * (n0 / 32) : 64 * ((n0 - DFF) / 32) + 32;
    const int c = lane & 7;
#pragma unroll
    for (int j = 0; j < 4; ++j) {
        const int n = (lane >> 3) + 8 * j;
        const float* s = scr + (8 * c) * 33 + n;
        uint4 o; o.x = pk2(s[0], s[33]); o.y = pk2(s[66], s[99]); o.z = pk2(s[132], s[165]); o.w = pk2(s[198], s[231]);
        if (n < nvalid) *(uint4*)(WT + (size_t)(drow0 + n) * K + k0 + 8 * c) = o;
    }
    asm volatile("s_waitcnt lgkmcnt(0)" ::: "memory");
    __builtin_amdgcn_wave_barrier();
}

__device__ __forceinline__ void phase_wconv(const Params& p, int l, char* lds) {
    const int lane = otid() & 63, wave = otid() >> 6;
    float* scr = (float*)lds + wave * (64 * 33);
    const int gw = obid() * 8 + wave, ngw = gridDim.x * 8;
    constexpr int I_IN = 16 * 89, I_OUT = 16 * 32, I_GU = 16 * 176, I_DN = 44 * 32;
    for (int it = gw; it < I_IN + I_OUT + I_GU + I_DN; it += ngw) {
        int r = it;
        if (r < I_IN) { wconv_item(p.in[I_WIN] + (size_t)l * D * INW, D, INW, (bf16*)(p.ws + WS_WIN), r, 0, scr, lane); continue; } r -= I_IN;
        if (r < I_OUT) { wconv_item(p.in[I_WOUT] + (size_t)l * D * D, D, D, (bf16*)(p.ws + WS_WOUT), r, 0, scr, lane); continue; } r -= I_OUT;
        if (r < I_GU) { wconv_item(p.in[I_WGU] + (size_t)l * D * GUW, D, GUW, (bf16*)(p.ws + WS_WGU), r, 1, scr, lane); continue; } r -= I_GU;
        wconv_item(p.in[I_WDN] + (size_t)l * DFF * D, DFF, D, (bf16*)(p.ws + WS_WDN), r, 0, scr, lane);
    }
}

__device__ __forceinline__ void phase_rows(const Params& p, int l, int kind  ) {
    const int lane = otid() & 63, wave = otid() >> 6;
    const int gw = obid() * 8 + wave, ngw = gridDim.x * 8;
    const float* mod = (const float*)(p.ws + WS_MOD);
    const float* gnorm = p.in[I_GNORM];
    float* X = p.out + OUT_Y;
    const float* SRC = (const float*)(p.ws + WS_Z);
    bf16* H = (bf16*)(p.ws + WS_HY);
    for (int t = gw; t < T; t += ngw) {
        const int v = modvec(t);
        f32x4 x[4];
        const float* xin;
        bool has_src; const float* gate = nullptr; const float* gsrc = nullptr;
        if (kind == 0) {
            if (l == 0) { xin = (t < TCTX) ? p.in[I_XP] + (size_t)t * D : p.in[I_XS] + (size_t)(t - TCTX) * D; has_src = false; }
            else { xin = X + (size_t)t * D; has_src = true; gate = mod + ((size_t)(l - 1) * 3 + v) * 6144 + 5 * 1024; gsrc = gnorm + ((size_t)(l - 1) * 4 + 3) * D; }
        } else { xin = X + (size_t)t * D; has_src = true; gate = mod + ((size_t)l * 3 + v) * 6144 + 2 * 1024; gsrc = gnorm + ((size_t)l * 4 + 1) * D; }
#pragma unroll
        for (int j = 0; j < 4; ++j) x[j] = *(const f32x4*)(xin + 4 * lane + 256 * j);
        if (has_src) {
            f32x4 s[4]; float ss = 0.f;
#pragma unroll
            for (int j = 0; j < 4; ++j) { s[j] = *(const f32x4*)(SRC + (size_t)t * D + 4 * lane + 256 * j); ss += s[j][0] * s[j][0] + s[j][1] * s[j][1] + s[j][2] * s[j][2] + s[j][3] * s[j][3]; }
            const float rstd = rsqrtf(wave_sum(ss) * (1.f / D) + EPS);
#pragma unroll
            for (int j = 0; j < 4; ++j) {
                const f32x4 gt = *(const f32x4*)(gate + 4 * lane + 256 * j), gs = *(const f32x4*)(gsrc + 4 * lane + 256 * j);
#pragma unroll
                for (int e = 0; e < 4; ++e) x[j][e] += gt[e] * (s[j][e] * rstd * gs[e]);
            }
        }
        if (has_src || l == 0) {
#pragma unroll
            for (int j = 0; j < 4; ++j) *(f32x4*)(X + (size_t)t * D + 4 * lane + 256 * j) = x[j];
        }
        const bool want_h = (kind == 1) || (l < NL);
        if (want_h) {
            const int gi = (kind == 0) ? 0 : 2;
            const float* gn = gnorm + ((size_t)l * 4 + gi) * D;
            const float* sh = mod + ((size_t)l * 3 + v) * 6144 + (kind == 0 ? 0 : 3) * 1024;
            const float* sc = sh + 1024;
            float ss = 0.f;
#pragma unroll
            for (int j = 0; j < 4; ++j) ss += x[j][0] * x[j][0] + x[j][1] * x[j][1] + x[j][2] * x[j][2] + x[j][3] * x[j][3];
            const float rstd = rsqrtf(wave_sum(ss) * (1.f / D) + EPS);
#pragma unroll
            for (int j = 0; j < 4; ++j) {
                const f32x4 g = *(const f32x4*)(gn + 4 * lane + 256 * j), a = *(const f32x4*)(sc + 4 * lane + 256 * j), b = *(const f32x4*)(sh + 4 * lane + 256 * j);
                float h[4];
#pragma unroll
                for (int e = 0; e < 4; ++e) h[e] = (x[j][e] * rstd * g[e]) * (1.f + a[e]) + b[e];
                uint2 o; o.x = pk2(h[0], h[1]); o.y = pk2(h[2], h[3]);
                *(uint2*)(H + (size_t)t * D + 4 * lane + 256 * j) = o;
            }
        }
    }
}

__device__ __forceinline__ void phase_ybuild(const Params& p, int l) {
    const int lane = otid() & 63, wave = otid() >> 6;
    const int gw = obid() * 8 + wave, ngw = gridDim.x * 8;
    const bf16* O = (const bf16*)(p.ws + WS_O);
    const float* OB = (const float*)(p.ws + WS_OB);
    const float* Z = (const float*)(p.ws + WS_Z);
    bf16* Y = (bf16*)(p.ws + WS_HY);
    const float* ga = p.in[I_GOUTA] + (size_t)l * 384; const float* gc = p.in[I_GOUTC] + (size_t)l * 384; const float* gb = p.in[I_GONB] + (size_t)l * 64;
    for (int t = gw; t < T; t += ngw) {
        float a[6], c[6]; float sa = 0.f, sc = 0.f;
#pragma unroll
        for (int j = 0; j < 6; ++j) {
            a[j] = bf2f(O[(size_t)t * 768 + lane + 64 * j]); c[j] = bf2f(O[(size_t)t * 768 + 384 + lane + 64 * j]);
            sa += a[j] * a[j]; sc += c[j] * c[j];
        }
        const float ra = rsqrtf(wave_sum(sa) * (1.f / 384.f) + EPS), rc = rsqrtf(wave_sum(sc) * (1.f / 384.f) + EPS);
#pragma unroll
        for (int j = 0; j < 6; ++j) {
            Y[(size_t)t * D + lane + 64 * j] = f2bf(a[j] * ra * ga[lane + 64 * j]);
            Y[(size_t)t * D + 640 + lane + 64 * j] = f2bf(c[j] * rc * gc[lane + 64 * j]);
        }
#pragma unroll
        for (int hh = 0; hh < 4; ++hh) {
            const float o = OB[(size_t)t * 256 + hh * 64 + lane] + OB[(size_t)T * 256 + (size_t)t * 256 + hh * 64 + lane];
            const float r = rsqrtf(wave_sum(o * o) * (1.f / 64.f) + EPS);
            const float g = silu_f(Z[(size_t)t * ZW + ZC_BG + hh * 64 + lane]);
            Y[(size_t)t * D + 384 + hh * 64 + lane] = f2bf(o * r * gb[lane] * g);
        }
    }
}

template <int BM, int BN, int WM, int WN, int EPI>
__device__ __forceinline__ void phase_gemm(const Params& p, int l, const bf16* A, int lda, const bf16* Bt, int K, int tiles_n, char* lds) {
    constexpr int WTM = BM / WM, WTN = BN / WN, TM = WTM / 16, TN = WTN / 16;
    constexpr int LS = 72;
    constexpr int AP = BM * 8 / NTHR, BP = BN * 8 / NTHR;
    static_assert(WM * WN == 8, "8 waves");
    const int tid = otid(), lane = tid & 63, wave = tid >> 6;
    const int wm = wave / WN, wn = wave % WN;
    const int fr = lane & 15, fq = lane >> 4;
    constexpr int STG = (BM + BN) * LS;
    bf16* const sbase = (bf16*)lds;
    static_assert(2 * (BM + BN) * LS * 2 <= LDS_BYTES, "lds");
    const int tiles_m = T / BM, nunits = tiles_m * tiles_n, nk = K / 64;
    for (int u = obid(); u < nunits; u += gridDim.x) {
        const int tn_i = u / tiles_m, tm_i = u % tiles_m;
        const int m0 = tm_i * BM, n0 = tn_i * BN;
        f32x4 acc[TM][TN];
#pragma unroll
        for (int i = 0; i < TM; ++i)
#pragma unroll
            for (int j = 0; j < TN; ++j) acc[i][j] = (f32x4){0.f, 0.f, 0.f, 0.f};
        uint4 ra[AP], rb[BP];
        const bf16* Ab = A + (size_t)m0 * lda; const bf16* Bb = Bt + (size_t)n0 * K;
#pragma unroll
        for (int q = 0; q < AP; ++q) { const int c = tid + NTHR * q; ra[q] = *(const uint4*)(Ab + (size_t)(c >> 3) * lda + (c & 7) * 8); }
#pragma unroll
        for (int q = 0; q < BP; ++q) { const int c = tid + NTHR * q; rb[q] = *(const uint4*)(Bb + (size_t)(c >> 3) * K + (c & 7) * 8); }
#pragma unroll
        for (int q = 0; q < AP; ++q) { const int c = tid + NTHR * q; *(uint4*)(sbase + (c >> 3) * LS + (c & 7) * 8) = ra[q]; }
#pragma unroll
        for (int q = 0; q < BP; ++q) { const int c = tid + NTHR * q; *(uint4*)(sbase + BM * LS + (c >> 3) * LS + (c & 7) * 8) = rb[q]; }
        __syncthreads();
        for (int kt = 0; kt < nk; ++kt) {
            const int cur = kt & 1;
            if (kt + 1 < nk) {
                const int k0 = (kt + 1) * 64;
#pragma unroll
                for (int q = 0; q < AP; ++q) { const int c = tid + NTHR * q; ra[q] = *(const uint4*)(Ab + (size_t)(c >> 3) * lda + k0 + (c & 7) * 8); }
#pragma unroll
                for (int q = 0; q < BP; ++q) { const int c = tid + NTHR * q; rb[q] = *(const uint4*)(Bb + (size_t)(c >> 3) * K + k0 + (c & 7) * 8); }
            }
            const bf16* sa = sbase + cur * STG + (wm * WTM + fr) * LS + fq * 8;
            const bf16* sb = sbase + cur * STG + BM * LS + (wn * WTN + fr) * LS + fq * 8;
#pragma unroll
            for (int kk = 0; kk < 2; ++kk) {
                bf16x8 af[TM], bfr[TN];
#pragma unroll
                for (int i = 0; i < TM; ++i) af[i] = *(const bf16x8*)(sa + i * 16 * LS + kk * 32);
#pragma unroll
                for (int j = 0; j < TN; ++j) bfr[j] = *(const bf16x8*)(sb + j * 16 * LS + kk * 32);
#pragma unroll
                for (int i = 0; i < TM; ++i)
#pragma unroll
                    for (int j = 0; j < TN; ++j) acc[i][j] = __builtin_amdgcn_mfma_f32_16x16x32_bf16(bfr[j], af[i], acc[i][j], 0, 0, 0);
            }
            if (kt + 1 < nk) {
#pragma unroll
                for (int q = 0; q < AP; ++q) { const int c = tid + NTHR * q; *(uint4*)(sbase + (cur ^ 1) * STG + (c >> 3) * LS + (c & 7) * 8) = ra[q]; }
#pragma unroll
                for (int q = 0; q < BP; ++q) { const int c = tid + NTHR * q; *(uint4*)(sbase + (cur ^ 1) * STG + BM * LS + (c >> 3) * LS + (c & 7) * 8) = rb[q]; }
            }
            __syncthreads();
        }
#pragma unroll
        for (int i = 0; i < TM; ++i) {
            const int row = m0 + wm * WTM + 16 * i + fr;
            if constexpr (EPI == 0) {
                float* Z = (float*)(p.ws + WS_Z); bf16* CQ = (bf16*)(p.ws + WS_CQKV);
#pragma unroll
                for (int j = 0; j < TN; ++j) {
                    const int col = n0 + wn * WTN + 16 * j + 4 * fq;
                    const f32x4 v = acc[i][j];
                    if (col < ZW) { *(f32x4*)(Z + (size_t)row * ZW + col) = v; }
                    else if (col < INW) {
                        uint2 o; o.x = pk2(v[0], v[1]); o.y = pk2(v[2], v[3]);
                        *(uint2*)(CQ + (size_t)row * CW + (col - PC_CQ)) = o;
                        if (row < TCTX && col >= PC_CK) {
                            const int b = row >> 8, s = row & 255;
                            float* dst = (col < PC_CV) ? p.out + OUT_CK + ((size_t)(b * NL + l) * SEQ + s) * 384 + (col - PC_CK)
                                                       : p.out + OUT_CV + ((size_t)(b * NL + l) * SEQ + s) * 384 + (col - PC_CV);
                            *(f32x4*)dst = v;
                        }
                    }
                }
            } else if constexpr (EPI == 1) {
                float* C = (float*)(p.ws + WS_Z);
#pragma unroll
                for (int j = 0; j < TN; ++j) { const int col = n0 + wn * WTN + 16 * j + 4 * fq; *(f32x4*)(C + (size_t)row * D + col) = acc[i][j]; }
            } else {
                static_assert(EPI != 2 || (WTN == 64), "gate/up interleave needs 64-wide wave tiles");
                bf16* ACT = (bf16*)(p.ws + WS_D1);
                const int jb = (n0 + wn * WTN) / 64;
#pragma unroll
                for (int j = 0; j < 2; ++j) {
                    const f32x4 g = acc[i][j], uu = acc[i][j + 2];
                    float h[4];
#pragma unroll
                    for (int e = 0; e < 4; ++e) h[e] = silu_f(g[e]) * uu[e];
                    uint2 o; o.x = pk2(h[0], h[1]); o.y = pk2(h[2], h[3]);
                    *(uint2*)(ACT + (size_t)row * DFF + jb * 32 + 16 * j + 4 * fq) = o;
                }
            }
        }
    }
}

__device__ __forceinline__ void p_tokens(const Params& p, int l) {
    const int lane = otid() & 63, wave = otid() >> 6;
    const int gw = obid() * 8 + wave, ngw = gridDim.x * 8;
    const float* Z = (const float*)(p.ws + WS_Z);
    bf16* QKA = (bf16*)(p.ws + WS_QKA);
    const float* rc = (const float*)(p.ws + WS_ROPE); const float* rs = rc + 1024;
    const float gq = p.in[I_GQK][(size_t)l * 128 + lane], gk = p.in[I_GQK][(size_t)l * 128 + 64 + lane];
    for (int t = gw; t < T; t += ngw) {
        const bool lat = t >= TCTX;
        float cs = 1.f, sn = 0.f;
        if (lat) {
            const int pos = (t - TCTX) & 2047, row = pos >> 6, colp = pos & 63, i = lane & 31;
            const int idx = (i < 16) ? row * 16 + i : colp * 16 + (i - 16);
            cs = rc[idx]; sn = rs[idx];
        }
#pragma unroll
        for (int slot = 0; slot < 10; ++slot) {
            const float z = Z[(size_t)t * ZW + slot * 64 + lane];
            float y = z;
            if (slot < 8) {
                const float r = rsqrtf(wave_sum(z * z) * (1.f / 64.f) + EPS);
                y = z * r * (slot < 6 ? gq : gk);
                if (!lat) {
                    if (slot >= 6) { const int b = t >> 8, s = t & 255; p.out[OUT_AK + ((size_t)(b * NL + l) * SEQ + s) * 128 + (slot - 6) * 64 + lane] = y; }
                } else {
                    const float pr = __shfl_xor(y, 32);
                    y = (lane < 32) ? y * cs - pr * sn : pr * sn + y * cs;
                }
            } else if (!lat) {
                const int b = t >> 8, s = t & 255; p.out[OUT_AV + ((size_t)(b * NL + l) * SEQ + s) * 128 + (slot - 8) * 64 + lane] = z;
            }
            QKA[(size_t)t * 640 + slot * 64 + lane] = f2bf(y);
        }
    }
}

struct ChunkId { int lat, b, h, dir, n, L, tok0; };
__device__ __forceinline__ ChunkId decode_cd(int cd) {
    ChunkId c;
    if (cd < 1024) { c.lat = 0; const int chain = cd >> 2; c.n = cd & 3; c.dir = chain & 1; c.h = (chain >> 1) & 3; c.b = chain >> 3; c.L = SEQ; c.tok0 = c.b * SEQ; }
    else { const int r = cd - 1024; c.lat = 1; const int chain = r >> 5; c.n = r & 31; c.dir = chain & 1; c.h = (chain >> 1) & 3; c.b = chain >> 3; c.L = LSEQ; c.tok0 = TCTX + c.b * LSEQ; }
    return c;
}

__device__ __forceinline__ void d1_unit(const Params& p, int l, int cd, char* lds) {
    const int tid = otid();
    const ChunkId c = decode_cd(cd);
    const float* Z = (const float*)(p.ws + WS_Z);
    float* sq = (float*)lds;
    float* sk = sq + 64 * 65;
    float* svv = sk + 64 * 65;
    float* sL = svv + 64 * 65;
    float* rhs = sL + 64 * 65;
    float* sg = rhs + 64 * 129;
    float* sbeta = sg + 64;
    float* snrm = sbeta + 64;
    float* d1 = (float*)(p.ws + WS_D1) + (size_t)cd * 5 * 4096;
    const float* cw = p.in[I_CONVW] + (size_t)l * 3 * 768;
    for (int e = tid; e < 64 * 192; e += NTHR) {
        const int i = e / 192, ch = e % 192, part = ch >> 6, d = ch & 63;
        const int pos = c.n * 64 + i, s = c.dir ? (c.L - 1 - pos) : pos;
        const int cc = part * 256 + c.h * 64 + d;
        const float* zr = Z + (size_t)(c.tok0 + s) * ZW + ZC_BQKV + cc;
        const float xm = (s > 0) ? zr[-ZW] : 0.f, x0 = zr[0], xp = (s < c.L - 1) ? zr[ZW] : 0.f;
        const float y = silu_f(xm * cw[cc] + x0 * cw[768 + cc] + xp * cw[1536 + cc]);
        float* dst = (part == 0) ? sq : (part == 1 ? sk : svv);
        dst[i * 65 + d] = y;
    }
    if (tid < 64) {
        const int pos = c.n * 64 + tid, s = c.dir ? (c.L - 1 - pos) : pos;
        const float* zr = Z + (size_t)(c.tok0 + s) * ZW;
        sbeta[tid] = sigmoid_f(zr[ZC_BBETA + c.dir * 4 + c.h]);
        const float al = p.in[I_ALOG][(size_t)l * 8 + c.dir * 4 + c.h], dtb = p.in[I_DTB][(size_t)l * 8 + c.dir * 4 + c.h];
        sg[tid] = -__expf(al) * softplus_f(zr[ZC_BALPHA + c.dir * 4 + c.h] + dtb);
    }
    __syncthreads();
    if (tid < 128) {
        const float* m = (tid < 64) ? sq + tid * 65 : sk + (tid - 64) * 65;
        float ss = 0.f;
#pragma unroll 8
        for (int d = 0; d < 64; ++d) ss += m[d] * m[d];
        snrm[tid] = rsqrtf(ss + EPS) * (tid < 64 ? 0.125f : 1.f);
    } else if (tid == 128) {
        float a = 0.f;
#pragma unroll 4
        for (int i = 0; i < 64; ++i) { a += sg[i]; sg[i] = a; }
    }
    __syncthreads();
    for (int e = tid; e < 64 * 64; e += NTHR) { const int i = e >> 6, d = e & 63; sq[i * 65 + d] *= snrm[i]; sk[i * 65 + d] *= snrm[64 + i]; }
    __syncthreads();
    const float gl = sg[63];
    for (int e = tid; e < 64 * 64; e += NTHR) {
        const int i = e >> 6, j = e & 63;
        float dkk = 0.f, dqk = 0.f;
#pragma unroll 8
        for (int d = 0; d < 64; ++d) { const float kj = sk[j * 65 + d]; dkk += sk[i * 65 + d] * kj; dqk += sq[i * 65 + d] * kj; }
        const float dec = (i >= j) ? __expf(sg[i] - sg[j]) : 0.f;
        sL[i * 65 + j] = (i > j) ? sbeta[i] * dkk * dec : 0.f;
        d1[2 * 4096 + e] = dqk * dec;
        const float egi = __expf(sg[i]);
        rhs[i * 129 + j] = svv[i * 65 + j] * sbeta[i];
        rhs[i * 129 + 64 + j] = sk[i * 65 + j] * sbeta[i] * egi;
        d1[3 * 4096 + e] = sq[i * 65 + j] * egi;
        d1[4 * 4096 + e] = sk[j * 65 + i] * __expf(gl - sg[j]);
    }
    if (tid == 0) ((float*)(p.ws + WS_DEC))[cd] = __expf(gl);
    __syncthreads();
    if (tid < 128) {
#pragma unroll 1
        for (int i = 1; i < 64; ++i) {
            float a = rhs[i * 129 + tid];
#pragma unroll 4
            for (int j = 0; j < i; ++j) a -= sL[i * 65 + j] * rhs[j * 129 + tid];
            rhs[i * 129 + tid] = a;
        }
    }
    __syncthreads();
    for (int e = tid; e < 64 * 64; e += NTHR) { const int i = e >> 6, j = e & 63; d1[e] = rhs[i * 129 + j]; d1[4096 + e] = rhs[i * 129 + 64 + j]; }
    __syncthreads();
}

__device__ __forceinline__ void phase_p(const Params& p, int l, char* lds) {
    p_tokens(p, l);
    for (int cd = obid(); cd < NCD; cd += gridDim.x) d1_unit(p, l, cd, lds);
}

template <int RPT>
__device__ __forceinline__ void dot_rows(const float* mat, int r0, const float* vec, float (&acc)[RPT]) {
#pragma unroll 4
    for (int k4 = 0; k4 < 16; ++k4) {
        const f32x4 b = *(const f32x4*)(vec + 4 * k4);
#pragma unroll
        for (int r = 0; r < RPT; ++r) {
            const f32x4 a = *(const f32x4*)(mat + (r0 + r) * 68 + 4 * k4);
            acc[r] += a[0] * b[0] + a[1] * b[1] + a[2] * b[2] + a[3] * b[3];
        }
    }
}

template <int NC>
__device__ __forceinline__ void d2_unit(const Params& p, int l, int lat, int chain, int slice, char* lds) {
    constexpr int RPT = NC / 8;
    const int tid = otid();
    const int dir = chain & 1, h = (chain >> 1) & 3, b = chain >> 3;
    const int L = lat ? LSEQ : SEQ, nch = L / 64, tok0 = lat ? TCTX + b * LSEQ : b * SEQ;
    const int cd0 = lat ? 1024 + chain * 32 : chain * 4;
    const int c0 = slice * NC;
    float* mw = (float*)lds;
    float* mq = mw + 64 * 68;
    float* ma = mq + 64 * 68;
    float* mk = ma + 64 * 68;
    float* ST = mk + 64 * 68;
    float* VT = ST + NC * 68;
    const int c = tid % NC, ig = tid / NC, r0 = ig * RPT;
    float* OB = (float*)(p.ws + WS_OB) + (size_t)dir * T * 256;
    for (int e = tid; e < 64 * NC; e += NTHR) {
        const int k = e / NC, cc = e % NC;
        ST[cc * 68 + k] = lat ? p.in[I_SB][((((size_t)b * NL + l) * 2 + dir) * 4 + h) * 4096 + k * 64 + c0 + cc] : 0.f;
    }
    for (int n = 0; n < nch; ++n) {
        const float* d1 = (const float*)(p.ws + WS_D1) + (size_t)(cd0 + n) * 5 * 4096;
        const float dec = ((const float*)(p.ws + WS_DEC))[cd0 + n];
        __syncthreads();
        for (int e = tid; e < 1024; e += NTHR) {
            const int r = e >> 4, c4 = (e & 15) * 4;
            *(f32x4*)(mw + r * 68 + c4) = *(const f32x4*)(d1 + 4096 + r * 64 + c4);
            *(f32x4*)(mq + r * 68 + c4) = *(const f32x4*)(d1 + 3 * 4096 + r * 64 + c4);
            *(f32x4*)(ma + r * 68 + c4) = *(const f32x4*)(d1 + 2 * 4096 + r * 64 + c4);
            *(f32x4*)(mk + r * 68 + c4) = *(const f32x4*)(d1 + 4 * 4096 + r * 64 + c4);
        }
        __syncthreads();
        {
            float acc[RPT];
#pragma unroll
            for (int r = 0; r < RPT; ++r) acc[r] = 0.f;
            dot_rows<RPT>(mw, r0, ST + c * 68, acc);
#pragma unroll
            for (int r = 0; r < RPT; ++r) VT[c * 68 + r0 + r] = d1[(r0 + r) * 64 + c0 + c] - acc[r];
        }
        __syncthreads();
        float sn[RPT];
        {
            float acc[RPT];
#pragma unroll
            for (int r = 0; r < RPT; ++r) acc[r] = 0.f;
            dot_rows<RPT>(mq, r0, ST + c * 68, acc);
            dot_rows<RPT>(ma, r0, VT + c * 68, acc);
#pragma unroll
            for (int r = 0; r < RPT; ++r) {
                const int pos = n * 64 + r0 + r, s = dir ? (L - 1 - pos) : pos;
                OB[(size_t)(tok0 + s) * 256 + h * 64 + c0 + c] = acc[r];
            }
#pragma unroll
            for (int r = 0; r < RPT; ++r) sn[r] = 0.f;
            dot_rows<RPT>(mk, r0, VT + c * 68, sn);
#pragma unroll
            for (int r = 0; r < RPT; ++r) sn[r] += ST[c * 68 + r0 + r] * dec;
        }
        __syncthreads();
#pragma unroll
        for (int r = 0; r < RPT; ++r) ST[c * 68 + r0 + r] = sn[r];
    }
    __syncthreads();
    if (!lat) {
        for (int e = tid; e < 64 * NC; e += NTHR) {
            const int k = e / NC, cc = e % NC;
            p.out[OUT_SB + ((((size_t)b * NL + l) * 2 + dir) * 4 + h) * 4096 + k * 64 + c0 + cc] = ST[cc * 68 + k];
        }
    }
    __syncthreads();
}

struct AttnSeg { const bf16* K; const bf16* V; int stride; int nkeys; };

__device__ __forceinline__ void attn_unit(const bf16* Q, int qstride, AttnSeg s0, AttnSeg s1, int mode, int R0, int kr0, const float* rpb_h, bf16* O, int ostride, char* lds) {
    const int tid = otid(), lane = tid & 63, wave = tid >> 6;
    const int qi = lane & 15, g = lane >> 4;
    bf16* Ks = (bf16*)lds;
    bf16* Vt = Ks + 64 * 72;
    float* rp = (float*)(Vt + 64 * 72);
    if (mode == 1) { for (int i = tid; i < 465; i += NTHR) rp[i] = rpb_h[i]; }
    bf16x8 qf[2];
    qf[0] = *(const bf16x8*)(Q + (size_t)(wave * 16 + qi) * qstride + g * 8);
    qf[1] = *(const bf16x8*)(Q + (size_t)(wave * 16 + qi) * qstride + 32 + g * 8);
    float m = -INFINITY, lsum = 0.f;
    f32x4 o[4];
#pragma unroll
    for (int i = 0; i < 4; ++i) o[i] = (f32x4){0.f, 0.f, 0.f, 0.f};
    const int qr = R0 + (wave >> 2), qc = (wave & 3) * 16 + qi;
    const int rs = min(max(qr - 4, 0), 24), cst = min(max(qc - 8, 0), 48);
    for (int seg = 0; seg < 2; ++seg) {
        AttnSeg sg;
        sg.K = seg ? s1.K : s0.K; sg.V = seg ? s1.V : s0.V; sg.stride = seg ? s1.stride : s0.stride; sg.nkeys = seg ? s1.nkeys : s0.nkeys;
        for (int k0 = 0; k0 < sg.nkeys; k0 += 64) {
            __syncthreads();
            {
                const int key = tid >> 3, cc = tid & 7;
                const uint4 kv = *(const uint4*)(sg.K + (size_t)(k0 + key) * sg.stride + cc * 8);
                const uint4 vv = *(const uint4*)(sg.V + (size_t)(k0 + key) * sg.stride + cc * 8);
                *(uint4*)(Ks + key * 72 + cc * 8) = kv;
                const unsigned w[4] = {vv.x, vv.y, vv.z, vv.w};
#pragma unroll
                for (int e = 0; e < 4; ++e) { Vt[(cc * 8 + 2 * e) * 72 + key] = (bf16)(w[e] & 0xffffu); Vt[(cc * 8 + 2 * e + 1) * 72 + key] = (bf16)(w[e] >> 16); }
            }
            __syncthreads();
            const bool nb = (mode == 1 && seg == 0);
            const int kr = kr0 + (k0 >> 6);
            if (nb && (kr < rs || kr >= rs + 8)) continue;
            f32x4 s[4];
#pragma unroll
            for (int kt = 0; kt < 4; ++kt) {
                s[kt] = (f32x4){0.f, 0.f, 0.f, 0.f};
#pragma unroll
                for (int kk = 0; kk < 2; ++kk) {
                    const bf16x8 kf = *(const bf16x8*)(Ks + (kt * 16 + qi) * 72 + kk * 32 + g * 8);
                    s[kt] = __builtin_amdgcn_mfma_f32_16x16x32_bf16(kf, qf[kk], s[kt], 0, 0, 0);
                }
            }
            float tmax = -INFINITY;
#pragma unroll
            for (int kt = 0; kt < 4; ++kt)
#pragma unroll
                for (int i = 0; i < 4; ++i) {
                    float v = s[kt][i] * 0.125f;
                    if (nb) {
                        const int kc = kt * 16 + 4 * g + i;
                        const int dc = min(max(kc - qc + 15, 0), 30);
                        v += rp[(kr - qr + 7) * 31 + dc];
                        if (kc < cst || kc >= cst + 16) v = -INFINITY;
                    }
                    s[kt][i] = v; tmax = fmaxf(tmax, v);
                }
            tmax = fmaxf(tmax, __shfl_xor(tmax, 16)); tmax = fmaxf(tmax, __shfl_xor(tmax, 32));
            const float mn = fmaxf(m, tmax);
            const float mu = (mn == -INFINITY) ? 0.f : mn;
            const float alpha = __expf(m - mu);
            m = mn;
            float ps = 0.f;
#pragma unroll
            for (int kt = 0; kt < 4; ++kt)
#pragma unroll
                for (int i = 0; i < 4; ++i) { const float pv = __expf(s[kt][i] - mu); s[kt][i] = pv; ps += pv; }
            lsum = lsum * alpha + ps;
#pragma unroll
            for (int dt = 0; dt < 4; ++dt) { o[dt][0] *= alpha; o[dt][1] *= alpha; o[dt][2] *= alpha; o[dt][3] *= alpha; }
#pragma unroll
            for (int pp = 0; pp < 2; ++pp) {
                union { bf16x8 v; unsigned u[4]; } pf;
                pf.u[0] = pk2(s[2 * pp][0], s[2 * pp][1]); pf.u[1] = pk2(s[2 * pp][2], s[2 * pp][3]);
                pf.u[2] = pk2(s[2 * pp + 1][0], s[2 * pp + 1][1]); pf.u[3] = pk2(s[2 * pp + 1][2], s[2 * pp + 1][3]);
#pragma unroll
                for (int dt = 0; dt < 4; ++dt) {
                    union { bf16x8 v; uint2 h[2]; } vf;
                    vf.h[0] = *(const uint2*)(Vt + (dt * 16 + qi) * 72 + (2 * pp) * 16 + 4 * g);
                    vf.h[1] = *(const uint2*)(Vt + (dt * 16 + qi) * 72 + (2 * pp + 1) * 16 + 4 * g);
                    o[dt] = __builtin_amdgcn_mfma_f32_16x16x32_bf16(vf.v, pf.v, o[dt], 0, 0, 0);
                }
            }
        }
    }
    lsum += __shfl_xor(lsum, 16); lsum += __shfl_xor(lsum, 32);
    const float inv = 1.f / lsum;
#pragma unroll
    for (int dt = 0; dt < 4; ++dt) {
        uint2 w; w.x = pk2(o[dt][0] * inv, o[dt][1] * inv); w.y = pk2(o[dt][2] * inv, o[dt][3] * inv);
        *(uint2*)(O + (size_t)(wave * 16 + qi) * ostride + dt * 16 + 4 * g) = w;
    }
    __syncthreads();
}

constexpr int MIX_BLAT = 64, MIX_ALAT = 192, MIX_CLAT = 192, MIX_BCTX = 256, MIX_ACTX = 384, MIX_CCTX = 384;
constexpr int MIX_TOTAL = MIX_BLAT + MIX_ALAT + MIX_CLAT + MIX_BCTX + MIX_ACTX + MIX_CCTX;

__device__ __forceinline__ void phase_mix(const Params& p, int l, char* lds) {
    unsigned* ctr = (unsigned*)(p.ws + WS_CTR) + l * 64;
    int* su = (int*)(lds + LDS_BYTES - 16);
    const bf16* QKA = (const bf16*)(p.ws + WS_QKA);
    const bf16* CQ = (const bf16*)(p.ws + WS_CQKV);
    bf16* O = (bf16*)(p.ws + WS_O);
    for (;;) {
        __syncthreads();
        if (otid() == 0) *su = (int)atomicAdd(ctr, 1u);
        __syncthreads();
        int u = *su;
        if (u >= MIX_TOTAL) break;
        if (u < MIX_BLAT) { d2_unit<16>(p, l, 1, u >> 2, u & 3, lds); continue; } u -= MIX_BLAT;
        if (u >= MIX_ALAT + MIX_CLAT && u < MIX_ALAT + MIX_CLAT + MIX_BCTX) { d2_unit<64>(p, l, 0, u - MIX_ALAT - MIX_CLAT, 0, lds); continue; }
        int kind;
        if (u < MIX_ALAT) kind = 0; else if (u < MIX_ALAT + MIX_CLAT) { kind = 1; u -= MIX_ALAT; }
        else { u -= MIX_ALAT + MIX_CLAT + MIX_BCTX; if (u < MIX_ACTX) kind = 2; else { kind = 3; u -= MIX_ACTX; } }
        const bool lat = kind < 2, isA = (kind & 1) == 0;
        const int b = lat ? u / 96 : u / 12, h = lat ? (u % 96) / 16 : (u % 12) / 2, qt = lat ? u % 16 : u % 2;
        const int t0 = lat ? TCTX + b * LSEQ : b * SEQ;
        const int kvh = h / 3;
        int R0 = 0, lo = 0;
        AttnSeg s0, s1;
        const bf16* Qp; int qstride; bf16* Op;
        if (isA) {
            s0.K = QKA + (size_t)t0 * 640 + 384 + kvh * 64; s0.V = QKA + (size_t)t0 * 640 + 512 + kvh * 64; s0.stride = 640; s0.nkeys = lat ? LSEQ : SEQ;
            s1.K = (const bf16*)(p.ws + WS_CAK) + ((size_t)(b * NL + l) * 256) * 128 + kvh * 64; s1.V = (const bf16*)(p.ws + WS_CAV) + ((size_t)(b * NL + l) * 256) * 128 + kvh * 64; s1.stride = 128;
            Qp = QKA + (size_t)(t0 + qt * 128) * 640 + h * 64; qstride = 640; Op = O + (size_t)(t0 + qt * 128) * 768 + h * 64;
        } else {
            int hi = 4;
            if (lat) { R0 = 2 * qt; lo = min(max(R0 - 4, 0), 24); hi = min(max(R0 + 1 - 4, 0), 24) + 8; }
            s0.K = CQ + (size_t)(t0 + lo * 64) * CW + 384 + h * 64; s0.V = CQ + (size_t)(t0 + lo * 64) * CW + 768 + h * 64; s0.stride = CW; s0.nkeys = (hi - lo) * 64;
            s1.K = (const bf16*)(p.ws + WS_CCK) + ((size_t)(b * NL + l) * 256) * 384 + h * 64; s1.V = (const bf16*)(p.ws + WS_CCV) + ((size_t)(b * NL + l) * 256) * 384 + h * 64; s1.stride = 384;
            Qp = CQ + (size_t)(t0 + qt * 128) * CW + h * 64; qstride = CW; Op = O + (size_t)(t0 + qt * 128) * 768 + 384 + h * 64;
        }
        s1.nkeys = lat ? 256 : 0;
        attn_unit(Qp, qstride, s0, s1, kind == 1 ? 1 : 0, R0, lo, p.in[I_RPB] + ((size_t)l * 6 + h) * 465, Op, 768, lds);
    }
}


#define LAS __attribute__((address_space(3)))
#define XB_TMO      128
#define XB_XCNT(j)  (256  + 64 * (j))
#define XB_XSUB(j)  (1280 + 64 * (j))
#define XB_XGEN(j)  (2304 + 64 * (j))
#define XB_TOP      3328
#define XB_TOPGEN   3392
#define XCD_BAR_WORDS 3456
#define XB_SPIN_CAP (1u << 18)
__device__ __forceinline__ unsigned xb_ld(unsigned* p)              { return __hip_atomic_load(p, __ATOMIC_RELAXED, __HIP_MEMORY_SCOPE_AGENT); }
__device__ __forceinline__ unsigned xb_add(unsigned* p, unsigned v) { return __hip_atomic_fetch_add(p, v, __ATOMIC_RELAXED, __HIP_MEMORY_SCOPE_AGENT); }
__device__ __forceinline__ unsigned xb_xcc_id() { return (unsigned)__builtin_amdgcn_s_getreg((3 << 11) | 20) & 0xFu; }
#define XB_SPIN(cond, bar) do { unsigned _sp = 0; while (cond) { __builtin_amdgcn_s_sleep(1); \
    if ((++_sp & 255u) == 0u) { if (xb_ld(&(bar)[XB_TMO])) break; if (_sp > XB_SPIN_CAP) { atomicAdd(&(bar)[XB_TMO], 1u); break; } } } } while (0)
struct XcdBarrier { unsigned* bar; unsigned x; volatile LAS unsigned* st; };
__device__ __forceinline__ XcdBarrier xcd_barrier_post(unsigned* bar, volatile LAS unsigned* st) {
    XcdBarrier b; b.bar = bar; b.x = xb_xcc_id(); b.st = st;
    if (threadIdx.x == 0) (void)xb_add(&bar[XB_XCNT(b.x)], 1u);
    return b;
}
__device__ __forceinline__ void xcd_barrier_complete(unsigned* bar, unsigned x, unsigned& nloc, unsigned& nx) {
    const unsigned G = gridDim.x * gridDim.y * gridDim.z;
    unsigned sum, cnt, mine, sp = 0u;
    for (;;) {
        sum = 0u; cnt = 0u; mine = 0u;
#pragma unroll
        for (unsigned j = 0; j < 16; ++j) { const unsigned c = xb_ld(&bar[XB_XCNT(j)]); sum += c; cnt += (c > 0u) ? 1u : 0u; mine = (j == x) ? c : mine; }
        if (sum == G) break;
        __builtin_amdgcn_s_sleep(1);
        if ((++sp & 255u) == 0u) { if (xb_ld(&bar[XB_TMO])) break; if (sp > XB_SPIN_CAP) { atomicAdd(&bar[XB_TMO], 1u); break; } }
    }
    nloc = mine > 0u ? mine : 1u; nx = cnt > 0u ? cnt : 1u;
}
__device__ __forceinline__ void xcd_barrier(const XcdBarrier& b) {
    asm volatile("s_waitcnt vmcnt(0)" ::: "memory");
    __syncthreads();
    if (threadIdx.x == 0) {
        unsigned* bar = b.bar;
        __builtin_amdgcn_s_waitcnt(0);
        unsigned nloc = b.st[0], nx = b.st[1];
        if (nloc == 0u) { xcd_barrier_complete(bar, b.x, nloc, nx); b.st[0] = nloc; b.st[1] = nx; }
        const unsigned old = xb_add(&bar[XB_XSUB(b.x)], 1u);
        const unsigned gen = old / nloc;
        if (old + 1u == (gen + 1u) * nloc) {
            __builtin_amdgcn_fence(__ATOMIC_RELEASE, "agent");
            asm volatile("s_waitcnt vmcnt(0)" ::: "memory");
            const unsigned og = xb_add(&bar[XB_TOP], 1u);
            const unsigned tg = og / nx;
            if (og + 1u == (tg + 1u) * nx) xb_add(&bar[XB_TOPGEN], 1u);
            else XB_SPIN(xb_ld(&bar[XB_TOPGEN]) == tg, bar);
            __builtin_amdgcn_fence(__ATOMIC_ACQUIRE, "agent");
            xb_add(&bar[XB_XGEN(b.x)], 1u);
            asm volatile("s_waitcnt vmcnt(0)" ::: "memory");
        } else {
            XB_SPIN(xb_ld(&bar[XB_XGEN(b.x)]) == gen, bar);
            __builtin_amdgcn_fence(__ATOMIC_ACQUIRE, "agent");
            asm volatile("s_waitcnt vmcnt(0)" ::: "memory");
        }
    }
    __syncthreads();
}

constexpr int PH_PER_LAYER = 9;
constexpr int N_PHASES = 1 + PH_PER_LAYER * DBG_LAYERS + 1;

__global__ void __launch_bounds__(NTHR) mega_kernel(Params p) {
    extern __shared__ __attribute__((aligned(16))) char lds[];
    cg::grid_group grid = cg::this_grid();
    volatile LAS unsigned* xst = (volatile LAS unsigned*)((LAS char*)lds + (LDS_BYTES - 64));
    if (threadIdx.x < 4) xst[threadIdx.x] = 0u;
    __syncthreads();
    const XcdBarrier xbar = xcd_barrier_post((unsigned*)(p.ws + WS_BAR), xst);
    for (int ph = p.ph_lo; ph < p.ph_hi; ++ph) {
        if (ph > p.ph_lo) { if (ph == p.ph_lo + 1) grid.sync(); else xcd_barrier(xbar); }
        if (ph == 0) { phase_prologue(p, lds); continue; }
        const bool last = (ph == N_PHASES - 1);
        const int l = last ? DBG_LAYERS : (ph - 1) / PH_PER_LAYER, s = last ? 9 : (ph - 1) % PH_PER_LAYER;
        if (s == 0) phase_wconv(p, l, lds);
        if (s == 0 || s == 6 || s == 9) phase_rows(p, l, s == 6 ? 1 : 0);
        else if (s == 1) phase_gemm<256, 128, 4, 2, 0>(p, l, (const bf16*)(p.ws + WS_HY), D, (const bf16*)(p.ws + WS_WIN), D, INWP / 128, lds);
        else if (s == 2) phase_p(p, l, lds);
        else if (s == 3) phase_mix(p, l, lds);
        else if (s == 4) phase_ybuild(p, l);
        else if (s == 7) phase_gemm<256, 128, 4, 2, 2>(p, l, (const bf16*)(p.ws + WS_HY), D, (const bf16*)(p.ws + WS_WGU), D, GUW / 128, lds);
        else {
            const bool dn = (s == 8);
            phase_gemm<128, 128, 2, 4, 1>(p, l, (const bf16*)(p.ws + (dn ? WS_D1 : WS_HY)), dn ? DFF : D, (const bf16*)(p.ws + (dn ? WS_WDN : WS_WOUT)), dn ? DFF : D, D / 128, lds);
        }
    }
}

extern "C" void kernel_launch(void* const* d_in, const int* in_sizes, int n_in, void* d_out, int out_size, void* d_ws, size_t ws_size, hipStream_t stream) {
    static int grid = 0;
    if (grid == 0) {
        if (n_in != 24 || ws_size < WS_END) { fprintf(stderr, "kernel_launch: unexpected n_in %d or ws_size %zu (need %zu)\n", n_in, ws_size, (size_t)WS_END); grid = -1; return; }
        int dev = 0, cus = 0, per_cu = 0;
        (void)hipGetDevice(&dev);
        (void)hipDeviceGetAttribute(&cus, hipDeviceAttributeMultiprocessorCount, dev);
        (void)hipFuncSetAttribute((const void*)mega_kernel, hipFuncAttributeMaxDynamicSharedMemorySize, LDS_BYTES);
        (void)hipOccupancyMaxActiveBlocksPerMultiprocessor(&per_cu, (const void*)mega_kernel, NTHR, LDS_BYTES);
        if (per_cu < 1) { fprintf(stderr, "kernel_launch: occupancy query says %d blocks per CU\n", per_cu); grid = -1; return; }
        grid = cus;
    }
    if (grid < 0) return;
    (void)hipMemsetAsync((char*)d_ws + WS_CTR, 0, WS_ZERO_BYTES, stream);
    Params p{};
    for (int i = 0; i < 24; ++i) p.in[i] = (const float*)d_in[i];
    p.out = (float*)d_out; p.ws = (unsigned char*)d_ws; p.ph_lo = 0; p.ph_hi = N_PHASES;
    void* args[] = {&p};
    hipError_t e = hipLaunchCooperativeKernel((const void*)mega_kernel, dim3(grid), dim3(NTHR), args, LDS_BYTES, stream);
    if (e != hipSuccess) fprintf(stderr, "cooperative launch failed: %s (grid %d)\n", hipGetErrorString(e), grid);
}
```

```cpp
#include <hip/hip_runtime.h>
#include <hip/hip_cooperative_groups.h>
#include <cstdio>
#include <cstdint>
namespace cg = cooperative_groups;

#ifndef DBG_LAYERS
#define DBG_LAYERS 4
#endif
#ifndef REPEAT_MASK
#define REPEAT_MASK 0
#endif

typedef unsigned short bf16;
typedef short bf16x8 __attribute__((ext_vector_type(8)));
typedef float f32x4 __attribute__((ext_vector_type(4)));

constexpr int D = 1024, TCTX = 8192, TLAT = 4096, T = TCTX + TLAT, NL = 4;
constexpr int SEQ = 256, LSEQ = 2048, NB_CTX = 32, NB_LAT = 2;
constexpr int INW = 2832, INWP = 2944, ZW = 1680, CW = 1152, DFF = 2816, GUW = 5632;
constexpr int NTHR = 512;
constexpr float EPS = 1e-6f;

constexpr int ZC_AQ = 0, ZC_AK = 384, ZC_AV = 512, ZC_BQKV = 640, ZC_BG = 1408, ZC_BBETA = 1664, ZC_BALPHA = 1672;
constexpr int PC_CQ = 1680, PC_CK = 2064, PC_CV = 2448;

constexpr size_t OUT_Y = 0;
constexpr size_t OUT_AK = 12582912, OUT_AV = 16777216, OUT_SB = 20971520, OUT_CK = 25165824, OUT_CV = 37748736;

constexpr size_t al256(size_t x) { return (x + 255) & ~(size_t)255; }
constexpr size_t WS_CTR = 0;
constexpr size_t WS_BAR = 4096;
constexpr size_t WS_ZERO_BYTES = 4096 + 16384;
constexpr size_t WS_MOD = WS_ZERO_BYTES;
constexpr size_t WS_ROPE = al256(WS_MOD + (size_t)NL * 3 * 6144 * 4);
constexpr size_t WS_CAK = al256(WS_ROPE + 2 * 64 * 16 * 4);
constexpr size_t WS_CAV = WS_CAK + (size_t)2 * 4 * 256 * 128 * 2;
constexpr size_t WS_CCK = WS_CAV + (size_t)2 * 4 * 256 * 128 * 2;
constexpr size_t WS_CCV = WS_CCK + (size_t)2 * 4 * 256 * 384 * 2;
constexpr size_t WS_WIN = al256(WS_CCV + (size_t)2 * 4 * 256 * 384 * 2);
constexpr size_t WS_WOUT = WS_WIN + (size_t)INWP * D * 2;
constexpr size_t WS_WGU = WS_WOUT + (size_t)D * D * 2;
constexpr size_t WS_WDN = WS_WGU + (size_t)GUW * D * 2;
constexpr size_t WS_HY = al256(WS_WDN + (size_t)D * DFF * 2);
constexpr size_t WS_Z = WS_HY + (size_t)T * D * 2;
constexpr size_t WS_CQKV = WS_Z + (size_t)T * ZW * 4;
constexpr size_t WS_QKA = WS_CQKV + (size_t)T * CW * 2;
constexpr size_t WS_D1 = WS_QKA + (size_t)T * 640 * 2;
constexpr int NCD = 1536;
constexpr size_t WS_ST = WS_D1 + (size_t)NCD * 4 * 4096 * 4;
constexpr size_t WS_O = WS_ST + (size_t)NCD * 4096 * 4;
constexpr size_t WS_END = WS_O + (size_t)T * 768 * 2;
static_assert((size_t)T * DFF * 2 <= (size_t)NCD * 4 * 4096 * 4, "ACT aliases D1");
static_assert((size_t)T * D * 4 <= (size_t)T * ZW * 4, "M/F alias Z");

constexpr int LDS_BYTES = 122880;

struct Params {
    const float* in[24];
    float* out;
    unsigned char* ws;
    int ph_lo, ph_hi;
};
enum { I_XP = 0, I_XS, I_CAK, I_CAV, I_SB, I_CCK, I_CCV, I_C, I_CCTX, I_WMOD, I_BMOD, I_GNORM, I_WIN, I_GQK, I_GOUTA, I_CONVW, I_ALOG, I_DTB,
       I_GONB, I_RPB, I_GOUTC, I_WOUT, I_WGU, I_WDN };

__device__ __forceinline__ int otid() { int t = threadIdx.x; asm volatile("" : "+v"(t)); return t; }
__device__ __forceinline__ int obid() { int b = blockIdx.x; asm volatile("" : "+s"(b)); return b; }
__device__ __forceinline__ bf16 f2bf(float f) { unsigned u = __float_as_uint(f); u += 0x7fffu + ((u >> 16) & 1u); return (bf16)(u >> 16); }
__device__ __forceinline__ float bf2f(bf16 h) { return __uint_as_float(((unsigned)h) << 16); }
__device__ __forceinline__ unsigned pk2(float lo, float hi) { return (unsigned)f2bf(lo) | ((unsigned)f2bf(hi) << 16); }
__device__ __forceinline__ float wave_sum(float v) {
#pragma unroll
    for (int o = 32; o >= 1; o >>= 1) v += __shfl_xor(v, o);
    return v;
}
__device__ __forceinline__ float silu_f(float x) { return x / (1.f + __expf(-x)); }
__device__ __forceinline__ float sigmoid_f(float x) { return 1.f / (1.f + __expf(-x)); }
__device__ __forceinline__ float softplus_f(float x) { return fmaxf(x, 0.f) + log1pf(__expf(-fabsf(x))); }
__device__ __forceinline__ int modvec(int t) { return t < TCTX ? 0 : 1 + ((t - TCTX) >> 11); }

__device__ __forceinline__ void phase_prologue(const Params& p, char* lds) {
    const int tid = otid();
    float* mod = (float*)(p.ws + WS_MOD);
    float* sv = (float*)lds;
    float* red = sv + 3 * 1024;
    for (int i = tid; i < 3 * 1024; i += NTHR) {
        const int v = i >> 10, k = i & 1023;
        const float c = (v == 0) ? p.in[I_CCTX][k] : p.in[I_C][(v - 1) * 1024 + k];
        sv[i] = silu_f(c);
    }
    __syncthreads();
    for (int u = obid(); u < NL * 96; u += gridDim.x) {
        const int l = u / 96, c0 = (u % 96) * 64;
        const int cg4 = tid & 15, kg = tid >> 4;
        const float* w = p.in[I_WMOD] + (size_t)l * 1024 * 6144 + c0 + cg4 * 4;
        float acc[3][4];
#pragma unroll
        for (int v = 0; v < 3; ++v)
#pragma unroll
            for (int e = 0; e < 4; ++e) acc[v][e] = 0.f;
#pragma unroll 8
        for (int kk = 0; kk < 32; ++kk) {
            const int k = kg * 32 + kk;
            const f32x4 wv = *(const f32x4*)(w + (size_t)k * 6144);
#pragma unroll
            for (int v = 0; v < 3; ++v) {
                const float s = sv[v * 1024 + k];
                acc[v][0] += s * wv[0]; acc[v][1] += s * wv[1]; acc[v][2] += s * wv[2]; acc[v][3] += s * wv[3];
            }
        }
#pragma unroll
        for (int v = 0; v < 3; ++v)
#pragma unroll
            for (int e = 0; e < 4; ++e) red[(kg * 16 + cg4) * 12 + v * 4 + e] = acc[v][e];
        __syncthreads();
        if (tid < 192) {
            const int v = tid >> 6, c = tid & 63;
            float s = 0.f;
            for (int g = 0; g < 32; ++g) s += red[(g * 16 + (c >> 2)) * 12 + v * 4 + (c & 3)];
            mod[((size_t)l * 3 + v) * 6144 + c0 + c] = s + p.in[I_BMOD][(size_t)l * 6144 + c0 + c];
        }
        __syncthreads();
    }
    {
        const size_t gt = (size_t)obid() * NTHR + tid, gn = (size_t)gridDim.x * NTHR;
        bf16* cak = (bf16*)(p.ws + WS_CAK); bf16* cav = (bf16*)(p.ws + WS_CAV);
        bf16* cck = (bf16*)(p.ws + WS_CCK); bf16* ccv = (bf16*)(p.ws + WS_CCV);
        for (size_t i = gt; i < (size_t)2 * 4 * 256 * 128; i += gn) { cak[i] = f2bf(p.in[I_CAK][i]); cav[i] = f2bf(p.in[I_CAV][i]); }
        for (size_t i = gt; i < (size_t)2 * 4 * 256 * 384; i += gn) { cck[i] = f2bf(p.in[I_CCK][i]); ccv[i] = f2bf(p.in[I_CCV][i]); }
    }
    if (obid() == 0) {
        float* rc = (float*)(p.ws + WS_ROPE); float* rs = rc + 1024;
        for (int i = tid; i < 1024; i += NTHR) {
            const int pos = i >> 4, f = i & 15;
            const float inv = exp2f(-(float)f * (13.287712379549449f / 16.f));
            const float ang = (float)pos * inv;
            const float rev = ang * 0.15915494309189535f;
            const float fr = rev - rintf(rev);
            const float r = fr * 6.283185307179586f;
            rc[i] = __cosf(r); rs[i] = __sinf(r);
        }
    }
}

__device__ __forceinline__ void wconv_item(const float* W, int K, int N, bf16* WT, int item, int mode, float* scr, int lane) {
    const int nblk = (N + 31) / 32, kb = item / nblk, nb = item % nblk, k0 = 64 * kb, n0 = 32 * nb;
    const int nvalid = min(32, N - n0);
    const int cl = lane & 31;
#pragma unroll 8
    for (int i = 0; i < 32; ++i) {
        const int kk = 2 * i + (lane >> 5);
        scr[kk * 33 + cl] = (cl < nvalid) ? W[(size_t)(k0 + kk) * N + n0 + cl] : 0.f;
    }
    asm volatile("s_waitcnt lgkmcnt(0)" ::: "memory");
    __builtin_amdgcn_wave_barrier();
    int drow0 = n0;
    if (mode == 1) drow0 = (n0 < DFF) ? 64 * (n0 / 32) : 64 * ((n0 - DFF) / 32) + 32;
    const int c = lane & 7;
#pragma unroll
    for (int j = 0; j < 4; ++j) {
        const int n = (lane >> 3) + 8 * j;
        const float* s = scr + (8 * c) * 33 + n;
        uint4 o; o.x = pk2(s[0], s[33]); o.y = pk2(s[66], s[99]); o.z = pk2(s[132], s[165]); o.w = pk2(s[198], s[231]);
        if (n < nvalid) *(uint4*)(WT + (size_t)(drow0 + n) * K + k0 + 8 * c) = o;
    }
    asm volatile("s_waitcnt lgkmcnt(0)" ::: "memory");
    __builtin_amdgcn_wave_barrier();
}

__device__ __forceinline__ void phase_wconv(const Params& p, int l, char* lds) {
    const int lane = otid() & 63, wave = otid() >> 6;
    float* scr = (float*)lds + wave * (64 * 33);
    const int gw = obid() * 8 + wave, ngw = gridDim.x * 8;
    constexpr int I_IN = 16 * 89, I_OUT = 16 * 32, I_GU = 16 * 176, I_DN = 44 * 32;
    for (int it = gw; it < I_IN + I_OUT + I_GU + I_DN; it += ngw) {
        int r = it;
        if (r < I_IN) { wconv_item(p.in[I_WIN] + (size_t)l * D * INW, D, INW, (bf16*)(p.ws + WS_WIN), r, 0, scr, lane); continue; } r -= I_IN;
        if (r < I_OUT) { wconv_item(p.in[I_WOUT] + (size_t)l * D * D, D, D, (bf16*)(p.ws + WS_WOUT), r, 0, scr, lane); continue; } r -= I_OUT;
        if (r < I_GU) { wconv_item(p.in[I_WGU] + (size_t)l * D * GUW, D, GUW, (bf16*)(p.ws + WS_WGU), r, 1, scr, lane); continue; } r -= I_GU;
        wconv_item(p.in[I_WDN] + (size_t)l * DFF * D, DFF, D, (bf16*)(p.ws + WS_WDN), r, 0, scr, lane);
    }
}

__device__ __forceinline__ void phase_rows(const Params& p, int l, int kind  ) {
    const int lane = otid() & 63, wave = otid() >> 6;
    const int gw = obid() * 8 + wave, ngw = gridDim.x * 8;
    const float* mod = (const float*)(p.ws + WS_MOD);
    const float* gnorm = p.in[I_GNORM];
    float* X = p.out + OUT_Y;
    const float* SRC = (const float*)(p.ws + WS_Z);
    bf16* H = (bf16*)(p.ws + WS_HY);
    for (int t = gw; t < T; t += ngw) {
        const int v = modvec(t);
        f32x4 x[4];
        const float* xin;
        bool has_src; const float* gate = nullptr; const float* gsrc = nullptr;
        if (kind == 0) {
            if (l == 0) { xin = (t < TCTX) ? p.in[I_XP] + (size_t)t * D : p.in[I_XS] + (size_t)(t - TCTX) * D; has_src = false; }
            else { xin = X + (size_t)t * D; has_src = true; gate = mod + ((size_t)(l - 1) * 3 + v) * 6144 + 5 * 1024; gsrc = gnorm + ((size_t)(l - 1) * 4 + 3) * D; }
        } else { xin = X + (size_t)t * D; has_src = true; gate = mod + ((size_t)l * 3 + v) * 6144 + 2 * 1024; gsrc = gnorm + ((size_t)l * 4 + 1) * D; }
#pragma unroll
        for (int j = 0; j < 4; ++j) x[j] = *(const f32x4*)(xin + 4 * lane + 256 * j);
        if (has_src) {
            f32x4 s[4]; float ss = 0.f;
#pragma unroll
            for (int j = 0; j < 4; ++j) { s[j] = *(const f32x4*)(SRC + (size_t)t * D + 4 * lane + 256 * j); ss += s[j][0] * s[j][0] + s[j][1] * s[j][1] + s[j][2] * s[j][2] + s[j][3] * s[j][3]; }
            const float rstd = rsqrtf(wave_sum(ss) * (1.f / D) + EPS);
#pragma unroll
            for (int j = 0; j < 4; ++j) {
                const f32x4 gt = *(const f32x4*)(gate + 4 * lane + 256 * j), gs = *(const f32x4*)(gsrc + 4 * lane + 256 * j);
#pragma unroll
                for (int e = 0; e < 4; ++e) x[j][e] += gt[e] * (s[j][e] * rstd * gs[e]);
            }
        }
        if (has_src || l == 0) {
#pragma unroll
            for (int j = 0; j < 4; ++j) *(f32x4*)(X + (size_t)t * D + 4 * lane + 256 * j) = x[j];
        }
        const bool want_h = (kind == 1) || (l < NL);
        if (want_h) {
            const int gi = (kind == 0) ? 0 : 2;
            const float* gn = gnorm + ((size_t)l * 4 + gi) * D;
            const float* sh = mod + ((size_t)l * 3 + v) * 6144 + (kind == 0 ? 0 : 3) * 1024;
            const float* sc = sh + 1024;
            float ss = 0.f;
#pragma unroll
            for (int j = 0; j < 4; ++j) ss += x[j][0] * x[j][0] + x[j][1] * x[j][1] + x[j][2] * x[j][2] + x[j][3] * x[j][3];
            const float rstd = rsqrtf(wave_sum(ss) * (1.f / D) + EPS);
#pragma unroll
            for (int j = 0; j < 4; ++j) {
                const f32x4 g = *(const f32x4*)(gn + 4 * lane + 256 * j), a = *(const f32x4*)(sc + 4 * lane + 256 * j), b = *(const f32x4*)(sh + 4 * lane + 256 * j);
                float h[4];
#pragma unroll
                for (int e = 0; e < 4; ++e) h[e] = (x[j][e] * rstd * g[e]) * (1.f + a[e]) + b[e];
                uint2 o; o.x = pk2(h[0], h[1]); o.y = pk2(h[2], h[3]);
                *(uint2*)(H + (size_t)t * D + 4 * lane + 256 * j) = o;
            }
        }
    }
}

__device__ __forceinline__ void d3_unit(const Params& p, int l, int u, char* lds);
__device__ __forceinline__ void phase_ybuild(const Params& p, int l, char* lds) {
    for (int u = obid(); u < 768; u += gridDim.x) d3_unit(p, l, u, lds);
    const int lane = otid() & 63, wave = otid() >> 6;
    const int gw = obid() * 8 + wave, ngw = gridDim.x * 8;
    const bf16* O = (const bf16*)(p.ws + WS_O);
    const float* Z = (const float*)(p.ws + WS_Z);
    bf16* Y = (bf16*)(p.ws + WS_HY);
    const float* ga = p.in[I_GOUTA] + (size_t)l * 384; const float* gc = p.in[I_GOUTC] + (size_t)l * 384; const float* gb = p.in[I_GONB] + (size_t)l * 64;
    for (int t = gw; t < T; t += ngw) {
        float a[6], c[6]; float sa = 0.f, sc = 0.f;
#pragma unroll
        for (int j = 0; j < 6; ++j) {
            a[j] = bf2f(O[(size_t)t * 768 + lane + 64 * j]); c[j] = bf2f(O[(size_t)t * 768 + 384 + lane + 64 * j]);
            sa += a[j] * a[j]; sc += c[j] * c[j];
        }
        const float ra = rsqrtf(wave_sum(sa) * (1.f / 384.f) + EPS), rc = rsqrtf(wave_sum(sc) * (1.f / 384.f) + EPS);
#pragma unroll
        for (int j = 0; j < 6; ++j) {
            Y[(size_t)t * D + lane + 64 * j] = f2bf(a[j] * ra * ga[lane + 64 * j]);
            Y[(size_t)t * D + 640 + lane + 64 * j] = f2bf(c[j] * rc * gc[lane + 64 * j]);
        }
    }
}

template <int BM, int BN, int WM, int WN, int EPI>
__device__ __forceinline__ void phase_gemm(const Params& p, int l, const bf16* A, int lda, const bf16* Bt, int K, int tiles_n, char* lds) {
    constexpr int WTM = BM / WM, WTN = BN / WN, TM = WTM / 16, TN = WTN / 16;
    constexpr int LS = 72;
    constexpr int AP = BM * 8 / NTHR, BP = BN * 8 / NTHR;
    static_assert(WM * WN == 8, "8 waves");
    const int tid = otid(), lane = tid & 63, wave = tid >> 6;
    const int wm = wave / WN, wn = wave % WN;
    const int fr = lane & 15, fq = lane >> 4;
    constexpr int STG = (BM + BN) * LS;
    bf16* const sbase = (bf16*)lds;
    static_assert(2 * (BM + BN) * LS * 2 <= LDS_BYTES, "lds");
    const int tiles_m = T / BM, nunits = tiles_m * tiles_n, nk = K / 64;
    for (int u = obid(); u < nunits; u += gridDim.x) {
        const int tn_i = u / tiles_m, tm_i = u % tiles_m;
        const int m0 = tm_i * BM, n0 = tn_i * BN;
        f32x4 acc[TM][TN];
#pragma unroll
        for (int i = 0; i < TM; ++i)
#pragma unroll
            for (int j = 0; j < TN; ++j) acc[i][j] = (f32x4){0.f, 0.f, 0.f, 0.f};
        uint4 ra[AP], rb[BP];
        const bf16* Ab = A + (size_t)m0 * lda; const bf16* Bb = Bt + (size_t)n0 * K;
#pragma unroll
        for (int q = 0; q < AP; ++q) { const int c = tid + NTHR * q; ra[q] = *(const uint4*)(Ab + (size_t)(c >> 3) * lda + (c & 7) * 8); }
#pragma unroll
        for (int q = 0; q < BP; ++q) { const int c = tid + NTHR * q; rb[q] = *(const uint4*)(Bb + (size_t)(c >> 3) * K + (c & 7) * 8); }
#pragma unroll
        for (int q = 0; q < AP; ++q) { const int c = tid + NTHR * q; *(uint4*)(sbase + (c >> 3) * LS + (c & 7) * 8) = ra[q]; }
#pragma unroll
        for (int q = 0; q < BP; ++q) { const int c = tid + NTHR * q; *(uint4*)(sbase + BM * LS + (c >> 3) * LS + (c & 7) * 8) = rb[q]; }
        __syncthreads();
        for (int kt = 0; kt < nk; ++kt) {
            const int cur = kt & 1;
            if (kt + 1 < nk) {
                const int k0 = (kt + 1) * 64;
#pragma unroll
                for (int q = 0; q < AP; ++q) { const int c = tid + NTHR * q; ra[q] = *(const uint4*)(Ab + (size_t)(c >> 3) * lda + k0 + (c & 7) * 8); }
#pragma unroll
                for (int q = 0; q < BP; ++q) { const int c = tid + NTHR * q; rb[q] = *(const uint4*)(Bb + (size_t)(c >> 3) * K + k0 + (c & 7) * 8); }
            }
            const bf16* sa = sbase + cur * STG + (wm * WTM + fr) * LS + fq * 8;
            const bf16* sb = sbase + cur * STG + BM * LS + (wn * WTN + fr) * LS + fq * 8;
#pragma unroll
            for (int kk = 0; kk < 2; ++kk) {
                bf16x8 af[TM], bfr[TN];
#pragma unroll
                for (int i = 0; i < TM; ++i) af[i] = *(const bf16x8*)(sa + i * 16 * LS + kk * 32);
#pragma unroll
                for (int j = 0; j < TN; ++j) bfr[j] = *(const bf16x8*)(sb + j * 16 * LS + kk * 32);
#pragma unroll
                for (int i = 0; i < TM; ++i)
#pragma unroll
                    for (int j = 0; j < TN; ++j) acc[i][j] = __builtin_amdgcn_mfma_f32_16x16x32_bf16(bfr[j], af[i], acc[i][j], 0, 0, 0);
            }
            if (kt + 1 < nk) {
#pragma unroll
                for (int q = 0; q < AP; ++q) { const int c = tid + NTHR * q; *(uint4*)(sbase + (cur ^ 1) * STG + (c >> 3) * LS + (c & 7) * 8) = ra[q]; }
#pragma unroll
                for (int q = 0; q < BP; ++q) { const int c = tid + NTHR * q; *(uint4*)(sbase + (cur ^ 1) * STG + BM * LS + (c >> 3) * LS + (c & 7) * 8) = rb[q]; }
            }
            __syncthreads();
        }
#pragma unroll
        for (int i = 0; i < TM; ++i) {
            const int row = m0 + wm * WTM + 16 * i + fr;
            if constexpr (EPI == 0) {
                float* Z = (float*)(p.ws + WS_Z); bf16* CQ = (bf16*)(p.ws + WS_CQKV);
#pragma unroll
                for (int j = 0; j < TN; ++j) {
                    const int col = n0 + wn * WTN + 16 * j + 4 * fq;
                    const f32x4 v = acc[i][j];
                    if (col < ZW) { *(f32x4*)(Z + (size_t)row * ZW + col) = v; }
                    else if (col < INW) {
                        uint2 o; o.x = pk2(v[0], v[1]); o.y = pk2(v[2], v[3]);
                        *(uint2*)(CQ + (size_t)row * CW + (col - PC_CQ)) = o;
                        if (row < TCTX && col >= PC_CK) {
                            const int b = row >> 8, s = row & 255;
                            float* dst = (col < PC_CV) ? p.out + OUT_CK + ((size_t)(b * NL + l) * SEQ + s) * 384 + (col - PC_CK)
                                                       : p.out + OUT_CV + ((size_t)(b * NL + l) * SEQ + s) * 384 + (col - PC_CV);
                            *(f32x4*)dst = v;
                        }
                    }
                }
            } else if constexpr (EPI == 1) {
                float* C = (float*)(p.ws + WS_Z);
#pragma unroll
                for (int j = 0; j < TN; ++j) { const int col = n0 + wn * WTN + 16 * j + 4 * fq; *(f32x4*)(C + (size_t)row * D + col) = acc[i][j]; }
            } else {
                static_assert(EPI != 2 || (WTN == 64), "gate/up interleave needs 64-wide wave tiles");
                bf16* ACT = (bf16*)(p.ws + WS_D1);
                const int jb = (n0 + wn * WTN) / 64;
#pragma unroll
                for (int j = 0; j < 2; ++j) {
                    const f32x4 g = acc[i][j], uu = acc[i][j + 2];
                    float h[4];
#pragma unroll
                    for (int e = 0; e < 4; ++e) h[e] = silu_f(g[e]) * uu[e];
                    uint2 o; o.x = pk2(h[0], h[1]); o.y = pk2(h[2], h[3]);
                    *(uint2*)(ACT + (size_t)row * DFF + jb * 32 + 16 * j + 4 * fq) = o;
                }
            }
        }
    }
}

__device__ __forceinline__ void p_tokens(const Params& p, int l) {
    const int lane = otid() & 63, wave = otid() >> 6;
    const int gw = obid() * 8 + wave, ngw = gridDim.x * 8;
    const float* Z = (const float*)(p.ws + WS_Z);
    bf16* QKA = (bf16*)(p.ws + WS_QKA);
    const float* rc = (const float*)(p.ws + WS_ROPE); const float* rs = rc + 1024;
    const float gq = p.in[I_GQK][(size_t)l * 128 + lane], gk = p.in[I_GQK][(size_t)l * 128 + 64 + lane];
    for (int t = gw; t < T; t += ngw) {
        const bool lat = t >= TCTX;
        float cs = 1.f, sn = 0.f;
        if (lat) {
            const int pos = (t - TCTX) & 2047, row = pos >> 6, colp = pos & 63, i = lane & 31;
            const int idx = (i < 16) ? row * 16 + i : colp * 16 + (i - 16);
            cs = rc[idx]; sn = rs[idx];
        }
#pragma unroll
        for (int slot = 0; slot < 10; ++slot) {
            const float z = Z[(size_t)t * ZW + slot * 64 + lane];
            float y = z;
            if (slot < 8) {
                const float r = rsqrtf(wave_sum(z * z) * (1.f / 64.f) + EPS);
                y = z * r * (slot < 6 ? gq : gk);
                if (!lat) {
                    if (slot >= 6) { const int b = t >> 8, s = t & 255; p.out[OUT_AK + ((size_t)(b * NL + l) * SEQ + s) * 128 + (slot - 6) * 64 + lane] = y; }
                } else {
                    const float pr = __shfl_xor(y, 32);
                    y = (lane < 32) ? y * cs - pr * sn : pr * sn + y * cs;
                }
            } else if (!lat) {
                const int b = t >> 8, s = t & 255; p.out[OUT_AV + ((size_t)(b * NL + l) * SEQ + s) * 128 + (slot - 8) * 64 + lane] = z;
            }
            QKA[(size_t)t * 640 + slot * 64 + lane] = f2bf(y);
        }
    }
}

struct ChunkId { int lat, b, h, dir, n, L, tok0; };
__device__ __forceinline__ ChunkId decode_cd(int cd) {
    ChunkId c;
    if (cd < 1024) { c.lat = 0; const int chain = cd >> 2; c.n = cd & 3; c.dir = chain & 1; c.h = (chain >> 1) & 3; c.b = chain >> 3; c.L = SEQ; c.tok0 = c.b * SEQ; }
    else { const int r = cd - 1024; c.lat = 1; const int chain = r >> 5; c.n = r & 31; c.dir = chain & 1; c.h = (chain >> 1) & 3; c.b = chain >> 3; c.L = LSEQ; c.tok0 = TCTX + c.b * LSEQ; }
    return c;
}

__device__ __forceinline__ void mm16(f32x4& acc, const float* Mx, int sm, const float* Nx, int sn, int nkb, int lane) {
    const float* pm = Mx + (lane & 15) * sm + (lane >> 4) * 4;
    const float* pn = Nx + (lane & 15) * sn + (lane >> 4) * 4;
    for (int kb = 0; kb < nkb; ++kb) {
        const f32x4 y = *(const f32x4*)(pm + kb * 16), x = *(const f32x4*)(pn + kb * 16);
        acc = __builtin_amdgcn_mfma_f32_16x16x4f32(x[0], y[0], acc, 0, 0, 0);
        acc = __builtin_amdgcn_mfma_f32_16x16x4f32(x[1], y[1], acc, 0, 0, 0);
        acc = __builtin_amdgcn_mfma_f32_16x16x4f32(x[2], y[2], acc, 0, 0, 0);
        acc = __builtin_amdgcn_mfma_f32_16x16x4f32(x[3], y[3], acc, 0, 0, 0);
    }
}
#define WAVE_LDS_FENCE() do { asm volatile("s_waitcnt lgkmcnt(0)" ::: "memory"); __builtin_amdgcn_wave_barrier(); } while (0)

__device__ __forceinline__ void d1_unit(const Params& p, int l, int cd, char* lds) {
    const int tid = otid(), lane = tid & 63, wave = tid >> 6;
    const ChunkId c = decode_cd(cd);
    const float* Z = (const float*)(p.ws + WS_Z);
    constexpr int S = 68;
    float* sq = (float*)lds;
    float* sk = sq + 64 * S;
    float* rT = sk + 64 * S;
    float* sa = rT + 128 * S;
    float* kgT = sa + 64 * S;
    float* Td = kgT + 64 * S;
    float* sg = Td + 4 * 16 * 20;
    float* sbeta = sg + 64;
    float* snrm = sbeta + 64;
    float* d1 = (float*)(p.ws + WS_D1) + (size_t)cd * 4 * 4096;
    const float* cw = p.in[I_CONVW] + (size_t)l * 3 * 768;
    for (int e = tid; e < 64 * 192; e += NTHR) {
        const int i = e / 192, ch = e % 192, part = ch >> 6, d = ch & 63;
        const int pos = c.n * 64 + i, s = c.dir ? (c.L - 1 - pos) : pos;
        const int cc = part * 256 + c.h * 64 + d;
        const float* zr = Z + (size_t)(c.tok0 + s) * ZW + ZC_BQKV + cc;
        const float xm = (s > 0) ? zr[-ZW] : 0.f, x0 = zr[0], xp = (s < c.L - 1) ? zr[ZW] : 0.f;
        const float y = silu_f(xm * cw[cc] + x0 * cw[768 + cc] + xp * cw[1536 + cc]);
        if (part == 0) sq[i * S + d] = y; else if (part == 1) sk[i * S + d] = y; else rT[d * S + i] = y;
    }
    if (tid < 64) {
        const int pos = c.n * 64 + tid, s = c.dir ? (c.L - 1 - pos) : pos;
        const float* zr = Z + (size_t)(c.tok0 + s) * ZW;
        sbeta[tid] = sigmoid_f(zr[ZC_BBETA + c.dir * 4 + c.h]);
        const float al = p.in[I_ALOG][(size_t)l * 8 + c.dir * 4 + c.h], dtb = p.in[I_DTB][(size_t)l * 8 + c.dir * 4 + c.h];
        sg[tid] = -__expf(al) * softplus_f(zr[ZC_BALPHA + c.dir * 4 + c.h] + dtb);
    }
    __syncthreads();
    if (tid < 128) {
        const float* m = (tid < 64) ? sq + tid * S : sk + (tid - 64) * S;
        float ss = 0.f;
#pragma unroll 4
        for (int d4 = 0; d4 < 16; ++d4) { const f32x4 v = *(const f32x4*)(m + 4 * d4); ss += v[0] * v[0] + v[1] * v[1] + v[2] * v[2] + v[3] * v[3]; }
        snrm[tid] = rsqrtf(ss + EPS) * (tid < 64 ? 0.125f : 1.f);
    } else if (tid == 128) {
        float a = 0.f;
#pragma unroll 4
        for (int i = 0; i < 64; ++i) { a += sg[i]; sg[i] = a; }
    }
    __syncthreads();
    for (int e = tid; e < 64 * 64; e += NTHR) { const int i = e >> 6, d = e & 63; sq[i * S + d] *= snrm[i]; sk[i * S + d] *= snrm[64 + i]; }
    __syncthreads();
    const float gl = sg[63];
    f32x4 t4[4];
    {
        const float* Mx = (wave < 4) ? sk : sq;
#pragma unroll
        for (int q4 = 0; q4 < 4; ++q4) {
            const int tt = (wave & 3) * 4 + q4, mi = tt >> 2, ni = tt & 3;
            t4[q4] = (f32x4){0.f, 0.f, 0.f, 0.f};
            if (mi >= ni) mm16(t4[q4], Mx + mi * 16 * S, S, sk + ni * 16 * S, S, 4, lane);
        }
    }
    for (int e = tid; e < 64 * 64; e += NTHR) {
        const int d = e >> 6, i = e & 63;
        const float kv = sk[i * S + d], b = sbeta[i], gi = sg[i];
        rT[(64 + d) * S + i] = kv * b * __expf(gi);
        kgT[d * S + i] = kv * __expf(gl - gi);
        rT[d * S + i] *= b;
    }
    __syncthreads();
    {
#pragma unroll
        for (int q4 = 0; q4 < 4; ++q4) {
            const int tt = (wave & 3) * 4 + q4, mi = tt >> 2, ni = tt & 3;
            const int i = mi * 16 + (lane & 15), j0 = ni * 16 + (lane >> 4) * 4;
            const float gi = sg[i], bi = sbeta[i];
            f32x4 o;
#pragma unroll
            for (int r = 0; r < 4; ++r) {
                const int j = j0 + r;
                const float dec = (i >= j) ? __expf(gi - sg[j]) : 0.f;
                o[r] = (wave < 4) ? ((i > j) ? bi * t4[q4][r] * dec : 0.f) : t4[q4][r] * dec;
            }
            *(f32x4*)(((wave < 4) ? sk : sa) + i * S + j0) = o;
        }
    }
    for (int e = tid; e < 64 * 64; e += NTHR) { const int i = e >> 6, d = e & 63; sq[i * S + d] *= __expf(sg[i]); }
    __syncthreads();
    if (tid < 64) {
        const int b = tid >> 4, cc = tid & 15;
        const float* Lb = sk + (16 * b) * S + 16 * b;
        float x[16];
#pragma unroll
        for (int i = 0; i < 16; ++i) {
            float a = (i == cc) ? 1.f : 0.f;
#pragma unroll
            for (int j = 0; j < i; ++j) a -= Lb[i * S + j] * x[j];
            x[i] = a;
            Td[(b * 16 + i) * 20 + cc] = a;
        }
    }
    __syncthreads();
    {
        float* rw = rT + (16 * wave) * S;
        float* my = rw + (lane & 15) * S + (lane >> 4) * 4;
#pragma unroll 1
        for (int bi = 0; bi < 4; ++bi) {
            f32x4 acc = (f32x4){0.f, 0.f, 0.f, 0.f};
            mm16(acc, rw, S, sk + (16 * bi) * S, S, bi, lane);
            f32x4 r = *(const f32x4*)(my + 16 * bi);
            r = r - acc;
            *(f32x4*)(my + 16 * bi) = r;
            WAVE_LDS_FENCE();
            f32x4 acc2 = (f32x4){0.f, 0.f, 0.f, 0.f};
            mm16(acc2, rw + 16 * bi, S, Td + bi * 16 * 20, 20, 1, lane);
            WAVE_LDS_FENCE();
            *(f32x4*)(my + 16 * bi) = acc2;
            WAVE_LDS_FENCE();
        }
    }
    __syncthreads();
    const float decl = __expf(gl);
#pragma unroll 1
    for (int q8 = 0; q8 < 8; ++q8) {
        const int t = wave * 8 + q8, pi = t >> 4, tt = t & 15, mi = tt >> 2, ni = tt & 3;
        const float* Mx = (pi == 0) ? kgT : (pi == 1 ? rT : sa);
        const float* Nx = (pi == 1) ? kgT : ((pi == 3) ? rT : rT + 64 * S);
        f32x4 acc = (f32x4){0.f, 0.f, 0.f, 0.f};
        mm16(acc, Mx + mi * 16 * S, S, Nx + ni * 16 * S, S, 4, lane);
        const int m = mi * 16 + (lane & 15), n0 = ni * 16 + (lane >> 4) * 4;
        f32x4 o = acc;
        if (pi == 0) {
#pragma unroll
            for (int r = 0; r < 4; ++r) o[r] = ((m == n0 + r) ? decl : 0.f) - acc[r];
        } else if (pi == 2) {
            const f32x4 qv = *(const f32x4*)(sq + m * S + n0);
            o = qv - acc;
        }
        *(f32x4*)(d1 + pi * 4096 + m * 64 + n0) = o;
    }
    __syncthreads();
}

__device__ __forceinline__ void phase_p(const Params& p, int l, char* lds) {
    p_tokens(p, l);
    for (int cd = obid(); cd < NCD; cd += gridDim.x) d1_unit(p, l, cd, lds);
}

template <int NC>
__device__ __forceinline__ void d2_unit(const Params& p, int l, int lat, int chain, int slice, char* lds) {
    constexpr int S = 68, NT = (NC / 16) * 4, TPW = (NT + 7) / 8;
    const int tid = otid(), lane = tid & 63, wave = tid >> 6;
    const int dir = chain & 1, h = (chain >> 1) & 3, b = chain >> 3;
    const int nch = lat ? LSEQ / 64 : SEQ / 64;
    const int cd0 = lat ? 1024 + chain * 32 : chain * 4;
    const int c0 = slice * NC;
    float* Ab = (float*)lds;
    float* ST = Ab + 2 * 64 * S;
    const float* d1 = (const float*)(p.ws + WS_D1);
    float* STg = (float*)(p.ws + WS_ST);
    for (int e = tid; e < 64 * NC; e += NTHR) {
        const int k = e / NC, cc = e % NC;
        ST[cc * S + k] = lat ? p.in[I_SB][((((size_t)b * NL + l) * 2 + dir) * 4 + h) * 4096 + k * 64 + c0 + cc] : 0.f;
    }
    f32x4 ar[2];
#pragma unroll
    for (int q = 0; q < 2; ++q) { const int e4 = tid + NTHR * q; ar[q] = *(const f32x4*)(d1 + (size_t)cd0 * 4 * 4096 + e4 * 4); }
#pragma unroll
    for (int q = 0; q < 2; ++q) { const int e4 = tid + NTHR * q; *(f32x4*)(Ab + (e4 >> 4) * S + (e4 & 15) * 4) = ar[q]; }
    __syncthreads();
    for (int n = 0; n < nch; ++n) {
        const float* dn = d1 + (size_t)(cd0 + n) * 4 * 4096;
        float* Acur = Ab + (n & 1) * 64 * S;
        for (int e4 = tid; e4 < NC * 16; e4 += NTHR) {
            const int cc = e4 >> 4, k4 = (e4 & 15) * 4;
            *(f32x4*)(STg + (size_t)(cd0 + n) * 4096 + (c0 + cc) * 64 + k4) = *(const f32x4*)(ST + cc * S + k4);
        }
        if (n + 1 < nch) {
#pragma unroll
            for (int q = 0; q < 2; ++q) { const int e4 = tid + NTHR * q; ar[q] = *(const f32x4*)(dn + 4 * 4096 + e4 * 4); }
        }
        f32x4 res[TPW];
#pragma unroll
        for (int q = 0; q < TPW; ++q) {
            const int t = wave * TPW + q;
            if (t < NT) {
                const int mi = t >> 2, ni = t & 3;
                const int m = mi * 16 + (lane & 15), n0 = ni * 16 + (lane >> 4) * 4;
                res[q] = *(const f32x4*)(dn + 4096 + (c0 + m) * 64 + n0);
                mm16(res[q], ST + mi * 16 * S, S, Acur + ni * 16 * S, S, 4, lane);
            }
        }
        __syncthreads();
#pragma unroll
        for (int q = 0; q < TPW; ++q) {
            const int t = wave * TPW + q;
            if (t < NT) {
                const int mi = t >> 2, ni = t & 3;
                const int m = mi * 16 + (lane & 15), n0 = ni * 16 + (lane >> 4) * 4;
                *(f32x4*)(ST + m * S + n0) = res[q];
            }
        }
        if (n + 1 < nch) {
            float* Anx = Ab + ((n + 1) & 1) * 64 * S;
#pragma unroll
            for (int q = 0; q < 2; ++q) { const int e4 = tid + NTHR * q; *(f32x4*)(Anx + (e4 >> 4) * S + (e4 & 15) * 4) = ar[q]; }
        }
        __syncthreads();
    }
    if (!lat) {
        for (int e = tid; e < 64 * NC; e += NTHR) {
            const int k = e / NC, cc = e % NC;
            p.out[OUT_SB + ((((size_t)b * NL + l) * 2 + dir) * 4 + h) * 4096 + k * 64 + c0 + cc] = ST[cc * S + k];
        }
    }
    __syncthreads();
}

__device__ __forceinline__ void d3_unit(const Params& p, int l, int u, char* lds) {
    constexpr int S = 68;
    const int tid = otid(), lane = tid & 63, wave = tid >> 6;
    int lat, b, h, n;
    if (u < 512) { lat = 0; b = u >> 4; h = (u >> 2) & 3; n = u & 3; } else { const int r = u - 512; lat = 1; b = r >> 7; h = (r >> 5) & 3; n = r & 31; }
    const int nch = lat ? 32 : 4;
    const int tok0 = (lat ? TCTX + b * LSEQ : b * SEQ) + n * 64;
    float* Cm = (float*)lds;
    float* Sm = Cm + 2 * 64 * S;
    float* osum = Sm + 2 * 64 * S;
    const float* d1 = (const float*)(p.ws + WS_D1);
    const float* STg = (const float*)(p.ws + WS_ST);
    int cdd[2];
#pragma unroll
    for (int dir = 0; dir < 2; ++dir) {
        const int chain = (b * 4 + h) * 2 + dir;
        cdd[dir] = (lat ? 1024 + chain * 32 : chain * 4) + (dir ? nch - 1 - n : n);
    }
#pragma unroll
    for (int q = 0; q < 4; ++q) {
        const int e4 = tid + NTHR * q, dir = e4 >> 10, r4 = e4 & 1023;
        const int cd = dir ? cdd[1] : cdd[0];
        *(f32x4*)(Cm + dir * 64 * S + (r4 >> 4) * S + (r4 & 15) * 4) = *(const f32x4*)(d1 + ((size_t)cd * 4 + 2) * 4096 + r4 * 4);
        *(f32x4*)(Sm + dir * 64 * S + (r4 >> 4) * S + (r4 & 15) * 4) = *(const f32x4*)(STg + (size_t)cd * 4096 + r4 * 4);
    }
    __syncthreads();
    const int dir = wave >> 2;
    const int cdw = dir ? cdd[1] : cdd[0];
    f32x4 res[4];
#pragma unroll
    for (int q = 0; q < 4; ++q) {
        const int t = (wave & 3) * 4 + q, mi = t >> 2, ni = t & 3;
        const int m = mi * 16 + (lane & 15), n0 = ni * 16 + (lane >> 4) * 4;
        res[q] = *(const f32x4*)(d1 + ((size_t)cdw * 4 + 3) * 4096 + m * 64 + n0);
        mm16(res[q], Cm + dir * 64 * S + mi * 16 * S, S, Sm + dir * 64 * S + ni * 16 * S, S, 4, lane);
    }
    if (dir == 0) {
#pragma unroll
        for (int q = 0; q < 4; ++q) { const int t = (wave & 3) * 4 + q, mi = t >> 2, ni = t & 3; *(f32x4*)(osum + (mi * 16 + (lane & 15)) * S + ni * 16 + (lane >> 4) * 4) = res[q]; }
    }
    __syncthreads();
    if (dir == 1) {
#pragma unroll
        for (int q = 0; q < 4; ++q) {
            const int t = (wave & 3) * 4 + q, mi = t >> 2, ni = t & 3;
            float* o = osum + (63 - (mi * 16 + (lane & 15))) * S + ni * 16 + (lane >> 4) * 4;
            f32x4 v = *(const f32x4*)o; v = v + res[q]; *(f32x4*)o = v;
        }
    }
    __syncthreads();
    {
        const int tok = tid >> 3, part = tid & 7, t = tok0 + tok;
        const f32x4 v0 = *(const f32x4*)(osum + tok * S + part * 8), v1 = *(const f32x4*)(osum + tok * S + part * 8 + 4);
        float ss = v0[0] * v0[0] + v0[1] * v0[1] + v0[2] * v0[2] + v0[3] * v0[3] + v1[0] * v1[0] + v1[1] * v1[1] + v1[2] * v1[2] + v1[3] * v1[3];
        ss += __shfl_xor(ss, 1); ss += __shfl_xor(ss, 2); ss += __shfl_xor(ss, 4);
        const float r = rsqrtf(ss * (1.f / 64.f) + EPS);
        const float* gz = (const float*)(p.ws + WS_Z) + (size_t)t * ZW + ZC_BG + h * 64 + part * 8;
        const float* gb = p.in[I_GONB] + (size_t)l * 64 + part * 8;
        const f32x4 z0 = *(const f32x4*)gz, z1 = *(const f32x4*)(gz + 4), g0 = *(const f32x4*)gb, g1 = *(const f32x4*)(gb + 4);
        float y[8];
#pragma unroll
        for (int e = 0; e < 4; ++e) { y[e] = v0[e] * r * g0[e] * silu_f(z0[e]); y[4 + e] = v1[e] * r * g1[e] * silu_f(z1[e]); }
        uint4 o; o.x = pk2(y[0], y[1]); o.y = pk2(y[2], y[3]); o.z = pk2(y[4], y[5]); o.w = pk2(y[6], y[7]);
        *(uint4*)((bf16*)(p.ws + WS_HY) + (size_t)t * D + 384 + h * 64 + part * 8) = o;
    }
    __syncthreads();
}

struct AttnSeg { const bf16* K; const bf16* V; int stride; int nkeys; };

__device__ __forceinline__ void attn_unit(const bf16* Q, int qstride, AttnSeg s0, AttnSeg s1, int mode, int R0, int kr0, const float* rpb_h, bf16* O, int ostride, char* lds) {
    const int tid = otid(), lane = tid & 63, wave = tid >> 6;
    const int qi = lane & 15, g = lane >> 4;
    bf16* Ks = (bf16*)lds;
    bf16* Vt = Ks + 64 * 72;
    float* rp = (float*)(Vt + 64 * 72);
    if (mode == 1) { for (int i = tid; i < 465; i += NTHR) rp[i] = rpb_h[i]; }
    bf16x8 qf[2];
    qf[0] = *(const bf16x8*)(Q + (size_t)(wave * 16 + qi) * qstride + g * 8);
    qf[1] = *(const bf16x8*)(Q + (size_t)(wave * 16 + qi) * qstride + 32 + g * 8);
    float m = -INFINITY, lsum = 0.f;
    f32x4 o[4];
#pragma unroll
    for (int i = 0; i < 4; ++i) o[i] = (f32x4){0.f, 0.f, 0.f, 0.f};
    const int qr = R0 + (wave >> 2), qc = (wave & 3) * 16 + qi;
    const int rs = min(max(qr - 4, 0), 24), cst = min(max(qc - 8, 0), 48);
    for (int seg = 0; seg < 2; ++seg) {
        AttnSeg sg;
        sg.K = seg ? s1.K : s0.K; sg.V = seg ? s1.V : s0.V; sg.stride = seg ? s1.stride : s0.stride; sg.nkeys = seg ? s1.nkeys : s0.nkeys;
        for (int k0 = 0; k0 < sg.nkeys; k0 += 64) {
            __syncthreads();
            {
                const int key = tid >> 3, cc = tid & 7;
                const uint4 kv = *(const uint4*)(sg.K + (size_t)(k0 + key) * sg.stride + cc * 8);
                const uint4 vv = *(const uint4*)(sg.V + (size_t)(k0 + key) * sg.stride + cc * 8);
                *(uint4*)(Ks + key * 72 + cc * 8) = kv;
                const unsigned w[4] = {vv.x, vv.y, vv.z, vv.w};
#pragma unroll
                for (int e = 0; e < 4; ++e) { Vt[(cc * 8 + 2 * e) * 72 + key] = (bf16)(w[e] & 0xffffu); Vt[(cc * 8 + 2 * e + 1) * 72 + key] = (bf16)(w[e] >> 16); }
            }
            __syncthreads();
            const bool nb = (mode == 1 && seg == 0);
            const int kr = kr0 + (k0 >> 6);
            if (nb && (kr < rs || kr >= rs + 8)) continue;
            f32x4 s[4];
#pragma unroll
            for (int kt = 0; kt < 4; ++kt) {
                s[kt] = (f32x4){0.f, 0.f, 0.f, 0.f};
#pragma unroll
                for (int kk = 0; kk < 2; ++kk) {
                    const bf16x8 kf = *(const bf16x8*)(Ks + (kt * 16 + qi) * 72 + kk * 32 + g * 8);
                    s[kt] = __builtin_amdgcn_mfma_f32_16x16x32_bf16(kf, qf[kk], s[kt], 0, 0, 0);
                }
            }
            float tmax = -INFINITY;
#pragma unroll
            for (int kt = 0; kt < 4; ++kt)
#pragma unroll
                for (int i = 0; i < 4; ++i) {
                    float v = s[kt][i] * 0.125f;
                    if (nb) {
                        const int kc = kt * 16 + 4 * g + i;
                        const int dc = min(max(kc - qc + 15, 0), 30);
                        v += rp[(kr - qr + 7) * 31 + dc];
                        if (kc < cst || kc >= cst + 16) v = -INFINITY;
                    }
                    s[kt][i] = v; tmax = fmaxf(tmax, v);
                }
            tmax = fmaxf(tmax, __shfl_xor(tmax, 16)); tmax = fmaxf(tmax, __shfl_xor(tmax, 32));
            const float mn = fmaxf(m, tmax);
            const float mu = (mn == -INFINITY) ? 0.f : mn;
            const float alpha = __expf(m - mu);
            m = mn;
            float ps = 0.f;
#pragma unroll
            for (int kt = 0; kt < 4; ++kt)
#pragma unroll
                for (int i = 0; i < 4; ++i) { const float pv = __expf(s[kt][i] - mu); s[kt][i] = pv; ps += pv; }
            lsum = lsum * alpha + ps;
#pragma unroll
            for (int dt = 0; dt < 4; ++dt) { o[dt][0] *= alpha; o[dt][1] *= alpha; o[dt][2] *= alpha; o[dt][3] *= alpha; }
#pragma unroll
            for (int pp = 0; pp < 2; ++pp) {
                union { bf16x8 v; unsigned u[4]; } pf;
                pf.u[0] = pk2(s[2 * pp][0], s[2 * pp][1]); pf.u[1] = pk2(s[2 * pp][2], s[2 * pp][3]);
                pf.u[2] = pk2(s[2 * pp + 1][0], s[2 * pp + 1][1]); pf.u[3] = pk2(s[2 * pp + 1][2], s[2 * pp + 1][3]);
#pragma unroll
                for (int dt = 0; dt < 4; ++dt) {
                    union { bf16x8 v; uint2 h[2]; } vf;
                    vf.h[0] = *(const uint2*)(Vt + (dt * 16 + qi) * 72 + (2 * pp) * 16 + 4 * g);
                    vf.h[1] = *(const uint2*)(Vt + (dt * 16 + qi) * 72 + (2 * pp + 1) * 16 + 4 * g);
                    o[dt] = __builtin_amdgcn_mfma_f32_16x16x32_bf16(vf.v, pf.v, o[dt], 0, 0, 0);
                }
            }
        }
    }
    lsum += __shfl_xor(lsum, 16); lsum += __shfl_xor(lsum, 32);
    const float inv = 1.f / lsum;
#pragma unroll
    for (int dt = 0; dt < 4; ++dt) {
        uint2 w; w.x = pk2(o[dt][0] * inv, o[dt][1] * inv); w.y = pk2(o[dt][2] * inv, o[dt][3] * inv);
        *(uint2*)(O + (size_t)(wave * 16 + qi) * ostride + dt * 16 + 4 * g) = w;
    }
    __syncthreads();
}

constexpr int MIX_BLAT = 64, MIX_ALAT = 192, MIX_CLAT = 192, MIX_BCTX = 256, MIX_ACTX = 384, MIX_CCTX = 384;
constexpr int MIX_TOTAL = MIX_BLAT + MIX_ALAT + MIX_CLAT + MIX_BCTX + MIX_ACTX + MIX_CCTX;

__device__ __forceinline__ void phase_mix(const Params& p, int l, char* lds, int rep) {
    unsigned* ctr = (unsigned*)(p.ws + WS_CTR) + l * 64 + rep * 16;
    int* su = (int*)(lds + LDS_BYTES - 16);
    const bf16* QKA = (const bf16*)(p.ws + WS_QKA);
    const bf16* CQ = (const bf16*)(p.ws + WS_CQKV);
    bf16* O = (bf16*)(p.ws + WS_O);
    for (;;) {
        __syncthreads();
        if (otid() == 0) *su = (int)atomicAdd(ctr, 1u);
        __syncthreads();
        int u = *su;
        if (u >= MIX_TOTAL) break;
        if (u < MIX_BLAT) { d2_unit<16>(p, l, 1, u >> 2, u & 3, lds); continue; } u -= MIX_BLAT;
        if (u >= MIX_ALAT + MIX_CLAT && u < MIX_ALAT + MIX_CLAT + MIX_BCTX) { d2_unit<64>(p, l, 0, u - MIX_ALAT - MIX_CLAT, 0, lds); continue; }
        int kind;
        if (u < MIX_ALAT) kind = 0; else if (u < MIX_ALAT + MIX_CLAT) { kind = 1; u -= MIX_ALAT; }
        else { u -= MIX_ALAT + MIX_CLAT + MIX_BCTX; if (u < MIX_ACTX) kind = 2; else { kind = 3; u -= MIX_ACTX; } }
        const bool lat = kind < 2, isA = (kind & 1) == 0;
        const int b = lat ? u / 96 : u / 12, h = lat ? (u % 96) / 16 : (u % 12) / 2, qt = lat ? u % 16 : u % 2;
        const int t0 = lat ? TCTX + b * LSEQ : b * SEQ;
        const int kvh = h / 3;
        int R0 = 0, lo = 0;
        AttnSeg s0, s1;
        const bf16* Qp; int qstride; bf16* Op;
        if (isA) {
            s0.K = QKA + (size_t)t0 * 640 + 384 + kvh * 64; s0.V = QKA + (size_t)t0 * 640 + 512 + kvh * 64; s0.stride = 640; s0.nkeys = lat ? LSEQ : SEQ;
            s1.K = (const bf16*)(p.ws + WS_CAK) + ((size_t)(b * NL + l) * 256) * 128 + kvh * 64; s1.V = (const bf16*)(p.ws + WS_CAV) + ((size_t)(b * NL + l) * 256) * 128 + kvh * 64; s1.stride = 128;
            Qp = QKA + (size_t)(t0 + qt * 128) * 640 + h * 64; qstride = 640; Op = O + (size_t)(t0 + qt * 128) * 768 + h * 64;
        } else {
            int hi = 4;
            if (lat) { R0 = 2 * qt; lo = min(max(R0 - 4, 0), 24); hi = min(max(R0 + 1 - 4, 0), 24) + 8; }
            s0.K = CQ + (size_t)(t0 + lo * 64) * CW + 384 + h * 64; s0.V = CQ + (size_t)(t0 + lo * 64) * CW + 768 + h * 64; s0.stride = CW; s0.nkeys = (hi - lo) * 64;
            s1.K = (const bf16*)(p.ws + WS_CCK) + ((size_t)(b * NL + l) * 256) * 384 + h * 64; s1.V = (const bf16*)(p.ws + WS_CCV) + ((size_t)(b * NL + l) * 256) * 384 + h * 64; s1.stride = 384;
            Qp = CQ + (size_t)(t0 + qt * 128) * CW + h * 64; qstride = CW; Op = O + (size_t)(t0 + qt * 128) * 768 + 384 + h * 64;
        }
        s1.nkeys = lat ? 256 : 0;
        attn_unit(Qp, qstride, s0, s1, kind == 1 ? 1 : 0, R0, lo, p.in[I_RPB] + ((size_t)l * 6 + h) * 465, Op, 768, lds);
    }
}


#define LAS __attribute__((address_space(3)))
#define XB_TMO      128
#define XB_XCNT(j)  (256  + 64 * (j))
#define XB_XSUB(j)  (1280 + 64 * (j))
#define XB_XGEN(j)  (2304 + 64 * (j))
#define XB_TOP      3328
#define XB_TOPGEN   3392
#define XCD_BAR_WORDS 3456
#define XB_SPIN_CAP (1u << 18)
__device__ __forceinline__ unsigned xb_ld(unsigned* p)              { return __hip_atomic_load(p, __ATOMIC_RELAXED, __HIP_MEMORY_SCOPE_AGENT); }
__device__ __forceinline__ unsigned xb_add(unsigned* p, unsigned v) { return __hip_atomic_fetch_add(p, v, __ATOMIC_RELAXED, __HIP_MEMORY_SCOPE_AGENT); }
__device__ __forceinline__ unsigned xb_xcc_id() { return (unsigned)__builtin_amdgcn_s_getreg((3 << 11) | 20) & 0xFu; }
#define XB_SPIN(cond, bar) do { unsigned _sp = 0; while (cond) { __builtin_amdgcn_s_sleep(1); \
    if ((++_sp & 255u) == 0u) { if (xb_ld(&(bar)[XB_TMO])) break; if (_sp > XB_SPIN_CAP) { atomicAdd(&(bar)[XB_TMO], 1u); break; } } } } while (0)
struct XcdBarrier { unsigned* bar; unsigned x; volatile LAS unsigned* st; };
__device__ __forceinline__ XcdBarrier xcd_barrier_post(unsigned* bar, volatile LAS unsigned* st) {
    XcdBarrier b; b.bar = bar; b.x = xb_xcc_id(); b.st = st;
    if (threadIdx.x == 0) (void)xb_add(&bar[XB_XCNT(b.x)], 1u);
    return b;
}
__device__ __forceinline__ void xcd_barrier_complete(unsigned* bar, unsigned x, unsigned& nloc, unsigned& nx) {
    const unsigned G = gridDim.x * gridDim.y * gridDim.z;
    unsigned sum, cnt, mine, sp = 0u;
    for (;;) {
        sum = 0u; cnt = 0u; mine = 0u;
#pragma unroll
        for (unsigned j = 0; j < 16; ++j) { const unsigned c = xb_ld(&bar[XB_XCNT(j)]); sum += c; cnt += (c > 0u) ? 1u : 0u; mine = (j == x) ? c : mine; }
        if (sum == G) break;
        __builtin_amdgcn_s_sleep(1);
        if ((++sp & 255u) == 0u) { if (xb_ld(&bar[XB_TMO])) break; if (sp > XB_SPIN_CAP) { atomicAdd(&bar[XB_TMO], 1u); break; } }
    }
    nloc = mine > 0u ? mine : 1u; nx = cnt > 0u ? cnt : 1u;
}
__device__ __forceinline__ void xcd_barrier(const XcdBarrier& b) {
    asm volatile("s_waitcnt vmcnt(0)" ::: "memory");
    __syncthreads();
    if (threadIdx.x == 0) {
        unsigned* bar = b.bar;
        __builtin_amdgcn_s_waitcnt(0);
        unsigned nloc = b.st[0], nx = b.st[1];
        if (nloc == 0u) { xcd_barrier_complete(bar, b.x, nloc, nx); b.st[0] = nloc; b.st[1] = nx; }
        const unsigned old = xb_add(&bar[XB_XSUB(b.x)], 1u);
        const unsigned gen = old / nloc;
        if (old + 1u == (gen + 1u) * nloc) {
            __builtin_amdgcn_fence(__ATOMIC_RELEASE, "agent");
            asm volatile("s_waitcnt vmcnt(0)" ::: "memory");
            const unsigned og = xb_add(&bar[XB_TOP], 1u);
            const unsigned tg = og / nx;
            if (og + 1u == (tg + 1u) * nx) xb_add(&bar[XB_TOPGEN], 1u);
            else XB_SPIN(xb_ld(&bar[XB_TOPGEN]) == tg, bar);
            __builtin_amdgcn_fence(__ATOMIC_ACQUIRE, "agent");
            xb_add(&bar[XB_XGEN(b.x)], 1u);
            asm volatile("s_waitcnt vmcnt(0)" ::: "memory");
        } else {
            XB_SPIN(xb_ld(&bar[XB_XGEN(b.x)]) == gen, bar);
            __builtin_amdgcn_fence(__ATOMIC_ACQUIRE, "agent");
            asm volatile("s_waitcnt vmcnt(0)" ::: "memory");
        }
    }
    __syncthreads();
}

constexpr int PH_PER_LAYER = 9;
constexpr int N_PHASES = 1 + PH_PER_LAYER * DBG_LAYERS + 1;

__global__ void __launch_bounds__(NTHR) mega_kernel(Params p) {
    extern __shared__ __attribute__((aligned(16))) char lds[];
    cg::grid_group grid = cg::this_grid();
    volatile LAS unsigned* xst = (volatile LAS unsigned*)((LAS char*)lds + (LDS_BYTES - 64));
    if (threadIdx.x < 4) xst[threadIdx.x] = 0u;
    __syncthreads();
    const XcdBarrier xbar = xcd_barrier_post((unsigned*)(p.ws + WS_BAR), xst);
    for (int ph = p.ph_lo; ph < p.ph_hi; ++ph) {
        if (ph > p.ph_lo) { if (ph == p.ph_lo + 1) grid.sync(); else xcd_barrier(xbar); }
        if (ph == 0) { phase_prologue(p, lds); continue; }
        const bool last = (ph == N_PHASES - 1);
        const int l = last ? DBG_LAYERS : (ph - 1) / PH_PER_LAYER, s = last ? 9 : (ph - 1) % PH_PER_LAYER;
        for (int rep = 0; rep < (((REPEAT_MASK >> s) & 1) ? 2 : 1); ++rep) {
        if (rep) xcd_barrier(xbar);
        if (s == 0) phase_wconv(p, l, lds);
        if (s == 0 || s == 6 || s == 9) phase_rows(p, l, s == 6 ? 1 : 0);
        else if (s == 1) phase_gemm<256, 128, 4, 2, 0>(p, l, (const bf16*)(p.ws + WS_HY), D, (const bf16*)(p.ws + WS_WIN), D, INWP / 128, lds);
        else if (s == 2) phase_p(p, l, lds);
        else if (s == 3) phase_mix(p, l, lds, rep);
        else if (s == 4) phase_ybuild(p, l, lds);
        else if (s == 7) phase_gemm<256, 128, 4, 2, 2>(p, l, (const bf16*)(p.ws + WS_HY), D, (const bf16*)(p.ws + WS_WGU), D, GUW / 128, lds);
        else {
            const bool dn = (s == 8);
            phase_gemm<128, 128, 2, 4, 1>(p, l, (const bf16*)(p.ws + (dn ? WS_D1 : WS_HY)), dn ? DFF : D, (const bf16*)(p.ws + (dn ? WS_WDN : WS_WOUT)), dn ? DFF : D, D / 128, lds);
        }
        }
    }
}

extern "C" void kernel_launch(void* const* d_in, const int* in_sizes, int n_in, void* d_out, int out_size, void* d_ws, size_t ws_size, hipStream_t stream) {
    static int grid = 0;
    if (grid == 0) {
        if (n_in != 24 || ws_size < WS_END) { fprintf(stderr, "kernel_launch: unexpected n_in %d or ws_size %zu (need %zu)\n", n_in, ws_size, (size_t)WS_END); grid = -1; return; }
        int dev = 0, cus = 0, per_cu = 0;
        (void)hipGetDevice(&dev);
        (void)hipDeviceGetAttribute(&cus, hipDeviceAttributeMultiprocessorCount, dev);
        (void)hipFuncSetAttribute((const void*)mega_kernel, hipFuncAttributeMaxDynamicSharedMemorySize, LDS_BYTES);
        (void)hipOccupancyMaxActiveBlocksPerMultiprocessor(&per_cu, (const void*)mega_kernel, NTHR, LDS_BYTES);
        if (per_cu < 1) { fprintf(stderr, "kernel_launch: occupancy query says %d blocks per CU\n", per_cu); grid = -1; return; }
        grid = cus;
    }
    if (grid < 0) return;
    (void)hipMemsetAsync((char*)d_ws + WS_CTR, 0, WS_ZERO_BYTES, stream);
    Params p{};
    for (int i = 0; i < 24; ++i) p.in[i] = (const float*)d_in[i];
    p.out = (float*)d_out; p.ws = (unsigned char*)d_ws; p.ph_lo = 0; p.ph_hi = N_PHASES;
    void* args[] = {&p};
    hipError_t e = hipLaunchCooperativeKernel((const void*)mega_kernel, dim3(grid), dim3(NTHR), args, LDS_BYTES, stream);
    if (e != hipSuccess) fprintf(stderr, "cooperative launch failed: %s (grid %d)\n", hipGetErrorString(e), grid);
}
```

```cpp
#include <hip/hip_runtime.h>
#include <hip/hip_cooperative_groups.h>
#include <cstdio>
#include <cstdint>
namespace cg = cooperative_groups;

#ifndef DBG_LAYERS
#define DBG_LAYERS 4
#endif
#ifndef REPEAT_MASK
#define REPEAT_MASK 0
#endif

typedef unsigned short bf16;
typedef short bf16x8 __attribute__((ext_vector_type(8)));
typedef float f32x4 __attribute__((ext_vector_type(4)));

constexpr int D = 1024, TCTX = 8192, TLAT = 4096, T = TCTX + TLAT, NL = 4;
constexpr int SEQ = 256, LSEQ = 2048, NB_CTX = 32, NB_LAT = 2;
constexpr int INW = 2832, INWP = 3072, ZW = 1680, CW = 1152, DFF = 2816, GUW = 5632;
constexpr int NTHR = 512;
constexpr float EPS = 1e-6f;

constexpr int ZC_AQ = 0, ZC_AK = 384, ZC_AV = 512, ZC_BQKV = 640, ZC_BG = 1408, ZC_BBETA = 1664, ZC_BALPHA = 1672;
constexpr int PC_CQ = 1680, PC_CK = 2064, PC_CV = 2448;

constexpr size_t OUT_Y = 0;
constexpr size_t OUT_AK = 12582912, OUT_AV = 16777216, OUT_SB = 20971520, OUT_CK = 25165824, OUT_CV = 37748736;

constexpr size_t al256(size_t x) { return (x + 255) & ~(size_t)255; }
constexpr size_t WS_CTR = 0;
constexpr size_t WS_BAR = 4096;
constexpr size_t WS_ZERO_BYTES = 4096 + 16384;
constexpr size_t WS_MOD = WS_ZERO_BYTES;
constexpr size_t WS_ROPE = al256(WS_MOD + (size_t)NL * 3 * 6144 * 4);
constexpr size_t WS_CAK = al256(WS_ROPE + 2 * 64 * 16 * 4);
constexpr size_t WS_CAV = WS_CAK + (size_t)2 * 4 * 256 * 128 * 2;
constexpr size_t WS_CCK = WS_CAV + (size_t)2 * 4 * 256 * 128 * 2;
constexpr size_t WS_CCV = WS_CCK + (size_t)2 * 4 * 256 * 384 * 2;
constexpr size_t WS_WIN = al256(WS_CCV + (size_t)2 * 4 * 256 * 384 * 2);
constexpr size_t WS_WOUT = WS_WIN + (size_t)INWP * D * 2;
constexpr size_t WS_WGU = WS_WOUT + (size_t)D * D * 2;
constexpr size_t WS_WDN = WS_WGU + (size_t)GUW * D * 2;
constexpr size_t WS_HY = al256(WS_WDN + (size_t)D * DFF * 2);
constexpr size_t WS_Z = WS_HY + (size_t)T * D * 2;
constexpr size_t WS_CQKV = WS_Z + (size_t)T * ZW * 4;
constexpr size_t WS_QKA = WS_CQKV + (size_t)T * CW * 2;
constexpr size_t WS_D1 = WS_QKA + (size_t)T * 640 * 2;
constexpr int NCD = 1536;
constexpr size_t WS_ST = WS_D1 + (size_t)NCD * 4 * 4096 * 4;
constexpr size_t WS_O = WS_ST + (size_t)NCD * 4096 * 4;
constexpr size_t WS_END = WS_O + (size_t)T * 768 * 2;
static_assert((size_t)T * DFF * 2 <= (size_t)NCD * 4 * 4096 * 4, "ACT aliases D1");
static_assert((size_t)T * D * 4 <= (size_t)T * ZW * 4, "M/F alias Z");

constexpr int LDS_BYTES = 135168;

struct Params {
    const float* in[24];
    float* out;
    unsigned char* ws;
    int ph_lo, ph_hi;
};
enum { I_XP = 0, I_XS, I_CAK, I_CAV, I_SB, I_CCK, I_CCV, I_C, I_CCTX, I_WMOD, I_BMOD, I_GNORM, I_WIN, I_GQK, I_GOUTA, I_CONVW, I_ALOG, I_DTB,
       I_GONB, I_RPB, I_GOUTC, I_WOUT, I_WGU, I_WDN };

__device__ __forceinline__ int otid() { int t = threadIdx.x; asm volatile("" : "+v"(t)); return t; }
__device__ __forceinline__ int obid() { int b = blockIdx.x; asm volatile("" : "+s"(b)); return b; }
__device__ __forceinline__ bf16 f2bf(float f) { unsigned u = __float_as_uint(f); u += 0x7fffu + ((u >> 16) & 1u); return (bf16)(u >> 16); }
__device__ __forceinline__ float bf2f(bf16 h) { return __uint_as_float(((unsigned)h) << 16); }
__device__ __forceinline__ unsigned pk2(float lo, float hi) { return (unsigned)f2bf(lo) | ((unsigned)f2bf(hi) << 16); }
__device__ __forceinline__ float wave_sum(float v) {
#pragma unroll
    for (int o = 32; o >= 1; o >>= 1) v += __shfl_xor(v, o);
    return v;
}
__device__ __forceinline__ float silu_f(float x) { return x / (1.f + __expf(-x)); }
__device__ __forceinline__ float sigmoid_f(float x) { return 1.f / (1.f + __expf(-x)); }
__device__ __forceinline__ float softplus_f(float x) { return fmaxf(x, 0.f) + log1pf(__expf(-fabsf(x))); }
__device__ __forceinline__ int modvec(int t) { return t < TCTX ? 0 : 1 + ((t - TCTX) >> 11); }

__device__ __forceinline__ void phase_prologue(const Params& p, char* lds) {
    const int tid = otid();
    float* mod = (float*)(p.ws + WS_MOD);
    float* sv = (float*)lds;
    float* red = sv + 3 * 1024;
    for (int i = tid; i < 3 * 1024; i += NTHR) {
        const int v = i >> 10, k = i & 1023;
        const float c = (v == 0) ? p.in[I_CCTX][k] : p.in[I_C][(v - 1) * 1024 + k];
        sv[i] = silu_f(c);
    }
    __syncthreads();
    for (int u = obid(); u < NL * 96; u += gridDim.x) {
        const int l = u / 96, c0 = (u % 96) * 64;
        const int cg4 = tid & 15, kg = tid >> 4;
        const float* w = p.in[I_WMOD] + (size_t)l * 1024 * 6144 + c0 + cg4 * 4;
        float acc[3][4];
#pragma unroll
        for (int v = 0; v < 3; ++v)
#pragma unroll
            for (int e = 0; e < 4; ++e) acc[v][e] = 0.f;
#pragma unroll 8
        for (int kk = 0; kk < 32; ++kk) {
            const int k = kg * 32 + kk;
            const f32x4 wv = *(const f32x4*)(w + (size_t)k * 6144);
#pragma unroll
            for (int v = 0; v < 3; ++v) {
                const float s = sv[v * 1024 + k];
                acc[v][0] += s * wv[0]; acc[v][1] += s * wv[1]; acc[v][2] += s * wv[2]; acc[v][3] += s * wv[3];
            }
        }
#pragma unroll
        for (int v = 0; v < 3; ++v)
#pragma unroll
            for (int e = 0; e < 4; ++e) red[(kg * 16 + cg4) * 12 + v * 4 + e] = acc[v][e];
        __syncthreads();
        if (tid < 192) {
            const int v = tid >> 6, c = tid & 63;
            float s = 0.f;
            for (int g = 0; g < 32; ++g) s += red[(g * 16 + (c >> 2)) * 12 + v * 4 + (c & 3)];
            mod[((size_t)l * 3 + v) * 6144 + c0 + c] = s + p.in[I_BMOD][(size_t)l * 6144 + c0 + c];
        }
        __syncthreads();
    }
    {
        const size_t gt = (size_t)obid() * NTHR + tid, gn = (size_t)gridDim.x * NTHR;
        bf16* cak = (bf16*)(p.ws + WS_CAK); bf16* cav = (bf16*)(p.ws + WS_CAV);
        bf16* cck = (bf16*)(p.ws + WS_CCK); bf16* ccv = (bf16*)(p.ws + WS_CCV);
        for (size_t i = gt; i < (size_t)2 * 4 * 256 * 128; i += gn) { cak[i] = f2bf(p.in[I_CAK][i]); cav[i] = f2bf(p.in[I_CAV][i]); }
        for (size_t i = gt; i < (size_t)2 * 4 * 256 * 384; i += gn) { cck[i] = f2bf(p.in[I_CCK][i]); ccv[i] = f2bf(p.in[I_CCV][i]); }
    }
    if (obid() == 0) {
        float* rc = (float*)(p.ws + WS_ROPE); float* rs = rc + 1024;
        for (int i = tid; i < 1024; i += NTHR) {
            const int pos = i >> 4, f = i & 15;
            const float inv = exp2f(-(float)f * (13.287712379549449f / 16.f));
            const float ang = (float)pos * inv;
            const float rev = ang * 0.15915494309189535f;
            const float fr = rev - rintf(rev);
            const float r = fr * 6.283185307179586f;
            rc[i] = __cosf(r); rs[i] = __sinf(r);
        }
    }
}

__device__ __forceinline__ void wconv_item(const float* W, int K, int N, bf16* WT, int item, int mode, float* scr, int lane) {
    const int nblk = (N + 31) / 32, kb = item / nblk, nb = item % nblk, k0 = 64 * kb, n0 = 32 * nb;
    const int nvalid = min(32, N - n0);
    const int cl = lane & 31;
#pragma unroll 8
    for (int i = 0; i < 32; ++i) {
        const int kk = 2 * i + (lane >> 5);
        scr[kk * 33 + cl] = (cl < nvalid) ? W[(size_t)(k0 + kk) * N + n0 + cl] : 0.f;
    }
    asm volatile("s_waitcnt lgkmcnt(0)" ::: "memory");
    __builtin_amdgcn_wave_barrier();
    const int c = lane & 7;
#pragma unroll
    for (int j = 0; j < 4; ++j) {
        const int n = (lane >> 3) + 8 * j;
        const float* s = scr + (8 * c) * 33 + n;
        uint4 o; o.x = pk2(s[0], s[33]); o.y = pk2(s[66], s[99]); o.z = pk2(s[132], s[165]); o.w = pk2(s[198], s[231]);
        int drow = n0 + n;
        if (mode == 1) { const int jj = (drow < DFF) ? drow : drow - DFF; drow = 32 * (jj >> 4) + (jj & 15) + ((drow < DFF) ? 0 : 16); }
        if (n < nvalid) *(uint4*)(WT + (size_t)drow * K + k0 + 8 * c) = o;
    }
    asm volatile("s_waitcnt lgkmcnt(0)" ::: "memory");
    __builtin_amdgcn_wave_barrier();
}

__device__ __forceinline__ void phase_wconv(const Params& p, int l, char* lds) {
    const int lane = otid() & 63, wave = otid() >> 6;
    float* scr = (float*)lds + wave * (64 * 33);
    const int gw = obid() * 8 + wave, ngw = gridDim.x * 8;
    constexpr int I_IN = 16 * 89, I_OUT = 16 * 32, I_GU = 16 * 176, I_DN = 44 * 32;
    for (int it = gw; it < I_IN + I_OUT + I_GU + I_DN; it += ngw) {
        int r = it;
        if (r < I_IN) { wconv_item(p.in[I_WIN] + (size_t)l * D * INW, D, INW, (bf16*)(p.ws + WS_WIN), r, 0, scr, lane); continue; } r -= I_IN;
        if (r < I_OUT) { wconv_item(p.in[I_WOUT] + (size_t)l * D * D, D, D, (bf16*)(p.ws + WS_WOUT), r, 0, scr, lane); continue; } r -= I_OUT;
        if (r < I_GU) { wconv_item(p.in[I_WGU] + (size_t)l * D * GUW, D, GUW, (bf16*)(p.ws + WS_WGU), r, 1, scr, lane); continue; } r -= I_GU;
        wconv_item(p.in[I_WDN] + (size_t)l * DFF * D, DFF, D, (bf16*)(p.ws + WS_WDN), r, 0, scr, lane);
    }
}

__device__ __forceinline__ void phase_rows(const Params& p, int l, int kind  ) {
    const int lane = otid() & 63, wave = otid() >> 6;
    const int gw = obid() * 8 + wave, ngw = gridDim.x * 8;
    const float* mod = (const float*)(p.ws + WS_MOD);
    const float* gnorm = p.in[I_GNORM];
    float* X = p.out + OUT_Y;
    const float* SRC = (const float*)(p.ws + WS_Z);
    bf16* H = (bf16*)(p.ws + WS_HY);
    for (int t = gw; t < T; t += ngw) {
        const int v = modvec(t);
        f32x4 x[4];
        const float* xin;
        bool has_src; const float* gate = nullptr; const float* gsrc = nullptr;
        if (kind == 0) {
            if (l == 0) { xin = (t < TCTX) ? p.in[I_XP] + (size_t)t * D : p.in[I_XS] + (size_t)(t - TCTX) * D; has_src = false; }
            else { xin = X + (size_t)t * D; has_src = true; gate = mod + ((size_t)(l - 1) * 3 + v) * 6144 + 5 * 1024; gsrc = gnorm + ((size_t)(l - 1) * 4 + 3) * D; }
        } else { xin = X + (size_t)t * D; has_src = true; gate = mod + ((size_t)l * 3 + v) * 6144 + 2 * 1024; gsrc = gnorm + ((size_t)l * 4 + 1) * D; }
#pragma unroll
        for (int j = 0; j < 4; ++j) x[j] = *(const f32x4*)(xin + 4 * lane + 256 * j);
        if (has_src) {
            f32x4 s[4]; float ss = 0.f;
#pragma unroll
            for (int j = 0; j < 4; ++j) { s[j] = *(const f32x4*)(SRC + (size_t)t * D + 4 * lane + 256 * j); ss += s[j][0] * s[j][0] + s[j][1] * s[j][1] + s[j][2] * s[j][2] + s[j][3] * s[j][3]; }
            const float rstd = rsqrtf(wave_sum(ss) * (1.f / D) + EPS);
#pragma unroll
            for (int j = 0; j < 4; ++j) {
                const f32x4 gt = *(const f32x4*)(gate + 4 * lane + 256 * j), gs = *(const f32x4*)(gsrc + 4 * lane + 256 * j);
#pragma unroll
                for (int e = 0; e < 4; ++e) x[j][e] += gt[e] * (s[j][e] * rstd * gs[e]);
            }
        }
        if (has_src || l == 0) {
#pragma unroll
            for (int j = 0; j < 4; ++j) *(f32x4*)(X + (size_t)t * D + 4 * lane + 256 * j) = x[j];
        }
        const bool want_h = (kind == 1) || (l < NL);
        if (want_h) {
            const int gi = (kind == 0) ? 0 : 2;
            const float* gn = gnorm + ((size_t)l * 4 + gi) * D;
            const float* sh = mod + ((size_t)l * 3 + v) * 6144 + (kind == 0 ? 0 : 3) * 1024;
            const float* sc = sh + 1024;
            float ss = 0.f;
#pragma unroll
            for (int j = 0; j < 4; ++j) ss += x[j][0] * x[j][0] + x[j][1] * x[j][1] + x[j][2] * x[j][2] + x[j][3] * x[j][3];
            const float rstd = rsqrtf(wave_sum(ss) * (1.f / D) + EPS);
#pragma unroll
            for (int j = 0; j < 4; ++j) {
                const f32x4 g = *(const f32x4*)(gn + 4 * lane + 256 * j), a = *(const f32x4*)(sc + 4 * lane + 256 * j), b = *(const f32x4*)(sh + 4 * lane + 256 * j);
                float h[4];
#pragma unroll
                for (int e = 0; e < 4; ++e) h[e] = (x[j][e] * rstd * g[e]) * (1.f + a[e]) + b[e];
                uint2 o; o.x = pk2(h[0], h[1]); o.y = pk2(h[2], h[3]);
                *(uint2*)(H + (size_t)t * D + 4 * lane + 256 * j) = o;
            }
        }
    }
}

__device__ __forceinline__ void d3_unit(const Params& p, int l, int u, char* lds);
__device__ __forceinline__ void phase_ybuild(const Params& p, int l, char* lds) {
    for (int u = obid(); u < 768; u += gridDim.x) d3_unit(p, l, u, lds);
    const int lane = otid() & 63, wave = otid() >> 6;
    const int gw = obid() * 8 + wave, ngw = gridDim.x * 8;
    const bf16* O = (const bf16*)(p.ws + WS_O);
    const float* Z = (const float*)(p.ws + WS_Z);
    bf16* Y = (bf16*)(p.ws + WS_HY);
    const float* ga = p.in[I_GOUTA] + (size_t)l * 384; const float* gc = p.in[I_GOUTC] + (size_t)l * 384; const float* gb = p.in[I_GONB] + (size_t)l * 64;
    for (int t = gw; t < T; t += ngw) {
        float a[6], c[6]; float sa = 0.f, sc = 0.f;
#pragma unroll
        for (int j = 0; j < 6; ++j) {
            a[j] = bf2f(O[(size_t)t * 768 + lane + 64 * j]); c[j] = bf2f(O[(size_t)t * 768 + 384 + lane + 64 * j]);
            sa += a[j] * a[j]; sc += c[j] * c[j];
        }
        const float ra = rsqrtf(wave_sum(sa) * (1.f / 384.f) + EPS), rc = rsqrtf(wave_sum(sc) * (1.f / 384.f) + EPS);
#pragma unroll
        for (int j = 0; j < 6; ++j) {
            Y[(size_t)t * D + lane + 64 * j] = f2bf(a[j] * ra * ga[lane + 64 * j]);
            Y[(size_t)t * D + 640 + lane + 64 * j] = f2bf(c[j] * rc * gc[lane + 64 * j]);
        }
    }
}

template <int BM, int BN, int WM, int WN, int EPI>
__device__ __forceinline__ void phase_gemm(const Params& p, int l, const bf16* A, int lda, const bf16* Bt, int K, int tiles_n, char* lds) {
    constexpr int WTM = BM / WM, WTN = BN / WN, TM = WTM / 16, TN = WTN / 16;
    constexpr int LS = 72;
    constexpr int AP = BM * 8 / NTHR, BP = BN * 8 / NTHR;
    static_assert(WM * WN == 8, "8 waves");
    const int tid = otid(), lane = tid & 63, wave = tid >> 6;
    const int wm = wave / WN, wn = wave % WN;
    const int fr = lane & 15, fq = lane >> 4;
    constexpr int STG = (BM + BN) * LS;
    bf16* const sbase = (bf16*)lds;
    static_assert(2 * (BM + BN) * LS * 2 <= LDS_BYTES, "lds");
    const int tiles_m = T / BM, nunits = tiles_m * tiles_n, nk = K / 64;
    for (int u = obid(); u < nunits; u += gridDim.x) {
        const int tn_i = u / tiles_m, tm_i = u % tiles_m;
        const int m0 = tm_i * BM, n0 = tn_i * BN;
        f32x4 acc[TM][TN];
#pragma unroll
        for (int i = 0; i < TM; ++i)
#pragma unroll
            for (int j = 0; j < TN; ++j) acc[i][j] = (f32x4){0.f, 0.f, 0.f, 0.f};
        uint4 ra[AP], rb[BP];
        const bf16* Ab = A + (size_t)m0 * lda; const bf16* Bb = Bt + (size_t)n0 * K;
#pragma unroll
        for (int q = 0; q < AP; ++q) { const int c = tid + NTHR * q; ra[q] = *(const uint4*)(Ab + (size_t)(c >> 3) * lda + (c & 7) * 8); }
#pragma unroll
        for (int q = 0; q < BP; ++q) { const int c = tid + NTHR * q; rb[q] = *(const uint4*)(Bb + (size_t)(c >> 3) * K + (c & 7) * 8); }
#pragma unroll
        for (int q = 0; q < AP; ++q) { const int c = tid + NTHR * q; *(uint4*)(sbase + (c >> 3) * LS + (c & 7) * 8) = ra[q]; }
#pragma unroll
        for (int q = 0; q < BP; ++q) { const int c = tid + NTHR * q; *(uint4*)(sbase + BM * LS + (c >> 3) * LS + (c & 7) * 8) = rb[q]; }
        __syncthreads();
        for (int kt = 0; kt < nk; ++kt) {
            const int cur = kt & 1;
            if (kt + 1 < nk) {
                const int k0 = (kt + 1) * 64;
#pragma unroll
                for (int q = 0; q < AP; ++q) { const int c = tid + NTHR * q; ra[q] = *(const uint4*)(Ab + (size_t)(c >> 3) * lda + k0 + (c & 7) * 8); }
#pragma unroll
                for (int q = 0; q < BP; ++q) { const int c = tid + NTHR * q; rb[q] = *(const uint4*)(Bb + (size_t)(c >> 3) * K + k0 + (c & 7) * 8); }
            }
            const bf16* sa = sbase + cur * STG + (wm * WTM + fr) * LS + fq * 8;
            const bf16* sb = sbase + cur * STG + BM * LS + (wn * WTN + fr) * LS + fq * 8;
#pragma unroll
            for (int kk = 0; kk < 2; ++kk) {
                bf16x8 af[TM], bfr[TN];
#pragma unroll
                for (int i = 0; i < TM; ++i) af[i] = *(const bf16x8*)(sa + i * 16 * LS + kk * 32);
#pragma unroll
                for (int j = 0; j < TN; ++j) bfr[j] = *(const bf16x8*)(sb + j * 16 * LS + kk * 32);
#pragma unroll
                for (int i = 0; i < TM; ++i)
#pragma unroll
                    for (int j = 0; j < TN; ++j) acc[i][j] = __builtin_amdgcn_mfma_f32_16x16x32_bf16(bfr[j], af[i], acc[i][j], 0, 0, 0);
            }
            if (kt + 1 < nk) {
#pragma unroll
                for (int q = 0; q < AP; ++q) { const int c = tid + NTHR * q; *(uint4*)(sbase + (cur ^ 1) * STG + (c >> 3) * LS + (c & 7) * 8) = ra[q]; }
#pragma unroll
                for (int q = 0; q < BP; ++q) { const int c = tid + NTHR * q; *(uint4*)(sbase + (cur ^ 1) * STG + BM * LS + (c >> 3) * LS + (c & 7) * 8) = rb[q]; }
            }
            __syncthreads();
        }
#pragma unroll
        for (int i = 0; i < TM; ++i) {
            const int row = m0 + wm * WTM + 16 * i + fr;
            if constexpr (EPI == 0) {
                float* Z = (float*)(p.ws + WS_Z); bf16* CQ = (bf16*)(p.ws + WS_CQKV);
#pragma unroll
                for (int j = 0; j < TN; ++j) {
                    const int col = n0 + wn * WTN + 16 * j + 4 * fq;
                    const f32x4 v = acc[i][j];
                    if (col < ZW) { *(f32x4*)(Z + (size_t)row * ZW + col) = v; }
                    else if (col < INW) {
                        uint2 o; o.x = pk2(v[0], v[1]); o.y = pk2(v[2], v[3]);
                        *(uint2*)(CQ + (size_t)row * CW + (col - PC_CQ)) = o;
                        if (row < TCTX && col >= PC_CK) {
                            const int b = row >> 8, s = row & 255;
                            float* dst = (col < PC_CV) ? p.out + OUT_CK + ((size_t)(b * NL + l) * SEQ + s) * 384 + (col - PC_CK)
                                                       : p.out + OUT_CV + ((size_t)(b * NL + l) * SEQ + s) * 384 + (col - PC_CV);
                            *(f32x4*)dst = v;
                        }
                    }
                }
            } else if constexpr (EPI == 1) {
                float* C = (float*)(p.ws + WS_Z);
#pragma unroll
                for (int j = 0; j < TN; ++j) { const int col = n0 + wn * WTN + 16 * j + 4 * fq; *(f32x4*)(C + (size_t)row * D + col) = acc[i][j]; }
            } else {
                static_assert(EPI != 2 || (WTN == 64), "gate/up interleave needs 64-wide wave tiles");
                bf16* ACT = (bf16*)(p.ws + WS_D1);
                const int jb = (n0 + wn * WTN) / 64;
#pragma unroll
                for (int j = 0; j < 2; ++j) {
                    const f32x4 g = acc[i][j], uu = acc[i][j + 2];
                    float h[4];
#pragma unroll
                    for (int e = 0; e < 4; ++e) h[e] = silu_f(g[e]) * uu[e];
                    uint2 o; o.x = pk2(h[0], h[1]); o.y = pk2(h[2], h[3]);
                    *(uint2*)(ACT + (size_t)row * DFF + jb * 32 + 16 * j + 4 * fq) = o;
                }
            }
        }
    }
}

namespace pg8 {
#define PG8_LAS __attribute__((address_space(3)))
typedef PG8_LAS unsigned char* LdsPtr;
typedef unsigned short bf16_t;
typedef short bf16x8 __attribute__((ext_vector_type(8)));
typedef float f32x4 __attribute__((ext_vector_type(4)));
typedef unsigned u32x4 __attribute__((ext_vector_type(4)));
constexpr int BM = 256, BK = 64, HALF = 128, HTB = HALF * BK * 2  , STAGE_BYTES = 8 * HTB, NXCD = 8, WGM = 8;

__host__ __device__ __forceinline__ int lds_byte(int r, int c) { const int st = (r >> 4) * 2 + (c >> 5), rr = r & 15, cc = c & 31, ob = rr * 64 + cc * 2; return st * 1024 + (ob ^ (((ob >> 9) & 1) << 5)); }
__host__ __device__ __forceinline__ void stage_rc(int b, int& R, int& C) { const int st = b / 1024, sb = b % 1024, swz = sb ^ (((sb >> 9) & 1) << 5); R = (st >> 1) * 16 + swz / 64; C = (st & 1) * 32 + (swz % 64) / 2; }
__host__ __device__ __forceinline__ int perm32(int rho) { const int n = rho >> 4, i = rho & 15; return 8 * (i >> 2) + 4 * n + (i & 3); }

struct Unit { int pm, pn; };
struct Gemm { const bf16_t* A; const bf16_t* Bt; int M, N, K; };

struct StaticOrder {
    int nM, nN, nwg, G, c;
    __host__ __device__ void init(int M, int N, int G_, int c_) { nM = M / BM; nN = N / BM; nwg = nM * nN; G = G_; c = c_; }
    __host__ __device__ bool next(int i, Unit& u) const {
        const long L = (long)i * G + c; if (L >= nwg) return false;
        int wgid = (int)L; { const int q = nwg / NXCD, r = nwg % NXCD, xcd = wgid % NXCD, off = wgid / NXCD; wgid = (xcd < r ? xcd * (q + 1) : r * (q + 1) + (xcd - r) * q) + off; }
        const int nig = WGM * nN, gid = wgid / nig, fm = gid * WGM, gsz = (nM - fm) < WGM ? (nM - fm) : WGM;
        u.pm = fm + ((wgid % nig) % gsz); u.pn = (wgid % nig) / gsz; return true;
    }
    __device__ __forceinline__ void a_ready(const Unit&) const {}
    __device__ __forceinline__ void done(const Unit&) const {}
};


__device__ __forceinline__ unsigned cvt_pk_bf16(float lo, float hi) { unsigned r; asm volatile("v_cvt_pk_bf16_f32 %0, %1, %2" : "=v"(r) : "v"(lo), "v"(hi)); return r; }


struct EpiInProj {
    static constexpr bool PERM = false, AFTER_DRAIN = false;
    float* Z; bf16_t* CQ; float* outk; float* outv; int l;
    __device__ __forceinline__ void operator()(const f32x4 (&acc)[2][2][4][2], const Unit& u, int wr, int wc, int fr, int fq) const {
#pragma unroll
        for (int ai = 0; ai < 2; ++ai)
#pragma unroll
            for (int m = 0; m < 4; ++m) {
                const int row = u.pm * BM + ai * HALF + wr * 64 + m * 16 + fr;
#pragma unroll
                for (int bj = 0; bj < 2; ++bj)
#pragma unroll
                    for (int n = 0; n < 2; ++n) {
                        const int col = u.pn * BM + bj * HALF + wc * 32 + n * 16 + 4 * fq;
                        const f32x4 v = acc[ai][bj][m][n];
                        if (col < ::ZW) { *(f32x4*)(Z + (size_t)row * ::ZW + col) = v; }
                        else if (col < ::INW) {
                            uint2 o; o.x = cvt_pk_bf16(v[0], v[1]); o.y = cvt_pk_bf16(v[2], v[3]);
                            *(uint2*)(CQ + (size_t)row * ::CW + (col - ::PC_CQ)) = o;
                            if (row < ::TCTX && col >= ::PC_CK) {
                                const int b = row >> 8, s = row & 255;
                                float* dst = (col < ::PC_CV) ? outk + ((size_t)(b * ::NL + l) * ::SEQ + s) * 384 + (col - ::PC_CK)
                                                             : outv + ((size_t)(b * ::NL + l) * ::SEQ + s) * 384 + (col - ::PC_CV);
                                *(f32x4*)dst = v;
                            }
                        }
                    }
            }
    }
};
struct EpiF32 {
    static constexpr bool PERM = false, AFTER_DRAIN = false;
    float* C; int ldc;
    __device__ __forceinline__ void operator()(const f32x4 (&acc)[2][2][4][2], const Unit& u, int wr, int wc, int fr, int fq) const {
#pragma unroll
        for (int ai = 0; ai < 2; ++ai)
#pragma unroll
            for (int m = 0; m < 4; ++m) {
                float* rowp = C + (size_t)(u.pm * BM + ai * HALF + wr * 64 + m * 16 + fr) * ldc + u.pn * BM + wc * 32 + 4 * fq;
#pragma unroll
                for (int bj = 0; bj < 2; ++bj)
#pragma unroll
                    for (int n = 0; n < 2; ++n) *(f32x4*)(rowp + bj * HALF + n * 16) = acc[ai][bj][m][n];
            }
    }
};
struct EpiSwiGLU {
    static constexpr bool PERM = false, AFTER_DRAIN = false;
    bf16_t* ACT; int ldc;
    __device__ __forceinline__ void operator()(const f32x4 (&acc)[2][2][4][2], const Unit& u, int wr, int wc, int fr, int fq) const {
#pragma unroll
        for (int ai = 0; ai < 2; ++ai)
#pragma unroll
            for (int m = 0; m < 4; ++m) {
                bf16_t* rowp = ACT + (size_t)(u.pm * BM + ai * HALF + wr * 64 + m * 16 + fr) * ldc;
#pragma unroll
                for (int bj = 0; bj < 2; ++bj) {
                    const int blk = (u.pn * BM + bj * HALF + wc * 32) >> 5;
                    const f32x4 g = acc[ai][bj][m][0], uu = acc[ai][bj][m][1];
                    float h[4];
#pragma unroll
                    for (int e = 0; e < 4; ++e) h[e] = g[e] / (1.f + __expf(-g[e])) * uu[e];
                    uint2 o; o.x = cvt_pk_bf16(h[0], h[1]); o.y = cvt_pk_bf16(h[2], h[3]);
                    *(uint2*)(rowp + blk * 16 + 4 * fq) = o;
                }
            }
    }
};

template <class Epi, class Sched, bool ALIGN_EPI = false, bool SP2 = false>
__device__ __forceinline__ void gemm_phase(PG8_LAS unsigned char* lds, const Gemm g, const Sched& S, const Epi& E) {
    const int tid = otid(), wid = __builtin_amdgcn_readfirstlane(tid >> 6), lane = tid & 63, wr = wid >> 2, wc = wid & 3, fr = lane & 15, fq = lane >> 4;
    const int K = g.K, nt = K / BK;
    unsigned voffA[2], voffB[2];
#pragma unroll
    for (int i = 0; i < 2; ++i) { int R, C; stage_rc(tid * 16 + i * 8192, R, C); const int Rb = Epi::PERM ? ((R & ~31) + perm32(R & 31)) : R;
        voffA[i] = (unsigned)(R * K + C) * 2u; voffB[i] = (unsigned)(Rb * K + C) * 2u; }
    const size_t kstep = (size_t)(BK * 2);
    const size_t hstep = (size_t)HALF * K * 2;
    const size_t tstep = 2 * hstep;
    const unsigned ldsw = (unsigned)wid * 1024u;
    const int aoff = lds_byte(wr * 64 + fr, fq * 8), boff = lds_byte(wc * 32 + fr, fq * 8);
#define PG8_SA(b, h) (((b) * 2 + (h)) * HTB)
#define PG8_SB(b, h) ((4 + (b) * 2 + (h)) * HTB)
#define PG8_STAGE(bufoff, gbase, voff) do { _Pragma("unroll") for (int _i = 0; _i < 2; ++_i) \
        __builtin_amdgcn_global_load_lds((const unsigned*)((const char*)(gbase) + (voff)[_i]), (PG8_LAS unsigned*)(lds + (bufoff) + ldsw + _i * 8192), 16, 0, 0); } while (0)
#define PG8_LDA(dst, b, h) do { _Pragma("unroll") for (int m = 0; m < 4; ++m) _Pragma("unroll") for (int k = 0; k < 2; ++k) dst[m][k] = *(const PG8_LAS bf16x8*)(lds + PG8_SA(b, h) + aoff + m * 2048 + k * 1024); } while (0)
#define PG8_LDB(dst, b, h) do { _Pragma("unroll") for (int n = 0; n < 2; ++n) _Pragma("unroll") for (int k = 0; k < 2; ++k) dst[n][k] = *(const PG8_LAS bf16x8*)(lds + PG8_SB(b, h) + boff + n * 2048 + k * 1024); } while (0)
#define PG8_MMA(ai, bj, At, Bt) do { __builtin_amdgcn_s_setprio(1); _Pragma("unroll") for (int m = 0; m < 4; ++m) _Pragma("unroll") for (int n = 0; n < 2; ++n) _Pragma("unroll") for (int k = 0; k < 2; ++k) \
        acc[ai][bj][m][n] = __builtin_amdgcn_mfma_f32_16x16x32_bf16(Bt[n][k], At[m][k], acc[ai][bj][m][n], 0, 0, 0); __builtin_amdgcn_s_setprio(0); } while (0)
#define PG8_WAIT_V(n) asm volatile("s_waitcnt vmcnt(" #n ")" ::: "memory")
#define PG8_WAIT_L(n) asm volatile("s_waitcnt lgkmcnt(" #n ")" ::: "memory")
#define PG8_BAR __builtin_amdgcn_s_barrier()
#define PG8_SCHED __builtin_amdgcn_sched_barrier(0)
    Unit cur, nxt; int ui = 0;
    if (!S.next(0, cur)) return;
    f32x4 acc[2][2][4][2];
#pragma unroll
    for (int a = 0; a < 2; ++a)
#pragma unroll
        for (int b = 0; b < 2; ++b)
#pragma unroll
            for (int m = 0; m < 4; ++m)
#pragma unroll
                for (int n = 0; n < 2; ++n) acc[a][b][m][n] = (f32x4){0.f, 0.f, 0.f, 0.f};
    bf16x8 At[4][2], B0[2][2], B1[2][2];
    const char* cA = (const char*)g.A + (size_t)cur.pm * tstep; const char* cB = (const char*)g.Bt + (size_t)cur.pn * tstep;
    S.a_ready(cur);
    if constexpr (SP2) {
        PG8_STAGE(PG8_SB(0, 0), cB, voffB); PG8_STAGE(PG8_SB(0, 1), cB + hstep, voffB); PG8_STAGE(PG8_SA(0, 0), cA, voffA); PG8_STAGE(PG8_SA(0, 1), cA + hstep, voffA);
        if (wr == 1) PG8_BAR;
        PG8_WAIT_V(2); PG8_BAR;
        PG8_STAGE(PG8_SB(1, 0), cB + kstep, voffB); PG8_STAGE(PG8_SA(1, 0), cA + kstep, voffA); PG8_STAGE(PG8_SB(1, 1), cB + hstep + kstep, voffB);
        PG8_WAIT_V(6); PG8_BAR;
    } else {
        PG8_STAGE(PG8_SB(0, 0), cB, voffB); PG8_STAGE(PG8_SA(0, 0), cA, voffA); PG8_STAGE(PG8_SB(0, 1), cB + hstep, voffB); PG8_STAGE(PG8_SA(0, 1), cA + hstep, voffA);
        if (wr == 1) PG8_BAR;
        PG8_WAIT_V(4); PG8_BAR;
        PG8_STAGE(PG8_SB(1, 0), cB + kstep, voffB); PG8_STAGE(PG8_SA(1, 0), cA + kstep, voffA); PG8_STAGE(PG8_SB(1, 1), cB + hstep + kstep, voffB);
        PG8_WAIT_V(6); PG8_BAR;
    }
    for (;;) {
        const bool has_next = S.next(ui + 1, nxt);
        const char* nA = has_next ? (const char*)g.A + (size_t)nxt.pm * tstep : cA; const char* nB = has_next ? (const char*)g.Bt + (size_t)nxt.pn * tstep : cB;
        for (int t = 0; t < nt; t += 2) {
            const bool last = (t == nt - 2);
            const char* a1 = cA + (size_t)(t + 1) * kstep;
            const char* a2 = last ? nA : cA + (size_t)(t + 2) * kstep; const char* b2 = last ? nB : cB + (size_t)(t + 2) * kstep;
            const char* a3 = a2 + kstep; const char* b3 = b2 + kstep;
            if (last && has_next) S.a_ready(nxt);
            if constexpr (SP2) {
            PG8_LDB(B0, 0, 0); PG8_LDB(B1, 0, 1); PG8_SCHED; PG8_LDA(At, 0, 0); PG8_STAGE(PG8_SA(1, 1), a1 + hstep, voffA);
            PG8_WAIT_V(8); PG8_WAIT_L(0); PG8_BAR; PG8_MMA(0, 0, At, B0); PG8_MMA(0, 1, At, B1); PG8_BAR; PG8_SCHED;
            PG8_LDA(At, 0, 1); PG8_STAGE(PG8_SB(0, 0), b2, voffB); PG8_STAGE(PG8_SB(0, 1), b2 + hstep, voffB); PG8_STAGE(PG8_SA(0, 0), a2, voffA);
            PG8_WAIT_V(8); PG8_WAIT_L(0); PG8_BAR; PG8_MMA(1, 0, At, B0); PG8_MMA(1, 1, At, B1); PG8_BAR; PG8_SCHED;
            PG8_LDB(B0, 1, 0); PG8_LDB(B1, 1, 1); PG8_SCHED; PG8_LDA(At, 1, 0); PG8_STAGE(PG8_SA(0, 1), a2 + hstep, voffA);
            PG8_WAIT_V(8); PG8_WAIT_L(0); PG8_BAR; PG8_MMA(0, 0, At, B0); PG8_MMA(0, 1, At, B1); PG8_BAR; PG8_SCHED;
            PG8_LDA(At, 1, 1); PG8_STAGE(PG8_SB(1, 0), b3, voffB); PG8_STAGE(PG8_SB(1, 1), b3 + hstep, voffB); PG8_STAGE(PG8_SA(1, 0), a3, voffA);
            PG8_WAIT_V(8); PG8_WAIT_L(0); PG8_BAR; PG8_MMA(1, 0, At, B0); PG8_MMA(1, 1, At, B1); PG8_BAR; PG8_SCHED;
            } else {
            PG8_LDB(B0, 0, 0); PG8_SCHED; PG8_LDA(At, 0, 0); PG8_STAGE(PG8_SA(1, 1), a1 + hstep, voffA);
            PG8_WAIT_L(8); PG8_BAR; PG8_WAIT_L(0); PG8_MMA(0, 0, At, B0); PG8_BAR; PG8_SCHED;
            PG8_LDB(B1, 0, 1); PG8_STAGE(PG8_SB(0, 0), b2, voffB);
            PG8_BAR; PG8_WAIT_L(0); PG8_MMA(0, 1, At, B1); PG8_BAR;
            PG8_LDA(At, 0, 1); PG8_STAGE(PG8_SA(0, 0), a2, voffA);
            PG8_BAR; PG8_WAIT_L(0); PG8_MMA(1, 0, At, B0); PG8_BAR; PG8_SCHED;
            PG8_STAGE(PG8_SB(0, 1), b2 + hstep, voffB);
            PG8_WAIT_V(6); PG8_BAR; PG8_MMA(1, 1, At, B1); PG8_BAR;
            PG8_LDB(B0, 1, 0); PG8_SCHED; PG8_LDA(At, 1, 0); PG8_STAGE(PG8_SA(0, 1), a2 + hstep, voffA);
            PG8_WAIT_L(8); PG8_BAR; PG8_WAIT_L(0); PG8_MMA(0, 0, At, B0); PG8_BAR; PG8_SCHED;
            PG8_LDB(B1, 1, 1); PG8_STAGE(PG8_SB(1, 0), b3, voffB);
            PG8_BAR; PG8_WAIT_L(0); PG8_MMA(0, 1, At, B1); PG8_BAR;
            PG8_LDA(At, 1, 1); PG8_STAGE(PG8_SA(1, 0), a3, voffA);
            PG8_BAR; PG8_WAIT_L(0); PG8_MMA(1, 0, At, B0); PG8_BAR; PG8_SCHED;
            PG8_STAGE(PG8_SB(1, 1), b3 + hstep, voffB);
            PG8_WAIT_V(6); PG8_BAR; PG8_MMA(1, 1, At, B1); PG8_BAR;
            }
        }
        if constexpr (ALIGN_EPI) { if (wr == 0) PG8_BAR; }
        if constexpr (!Epi::AFTER_DRAIN) { E(acc, cur, wr, wc, fr, fq); S.done(cur); }
        if (!has_next) break;
#pragma unroll
        for (int a = 0; a < 2; ++a)
#pragma unroll
            for (int b = 0; b < 2; ++b)
#pragma unroll
                for (int m = 0; m < 4; ++m)
#pragma unroll
                    for (int n = 0; n < 2; ++n) acc[a][b][m][n] = (f32x4){0.f, 0.f, 0.f, 0.f};
        cur = nxt; cA = nA; cB = nB; ++ui;
        if constexpr (ALIGN_EPI) { if (wr == 1) PG8_BAR; }
    }
    PG8_WAIT_V(0);
    if constexpr (!ALIGN_EPI) { if (wr == 0) PG8_BAR; }
    PG8_BAR;
    if constexpr (Epi::AFTER_DRAIN) { E.fused(acc, cur, wr, wc, fr, fq, lds, wid, lane); S.done(cur); }
#undef PG8_SA
#undef PG8_SB
#undef PG8_STAGE
#undef PG8_LDA
#undef PG8_LDB
#undef PG8_MMA
#undef PG8_WAIT_V
#undef PG8_WAIT_L
#undef PG8_BAR
#undef PG8_SCHED
}
}

__device__ __forceinline__ void p_tokens(const Params& p, int l) {
    const int lane = otid() & 63, wave = otid() >> 6;
    const int gw = obid() * 8 + wave, ngw = gridDim.x * 8;
    const float* Z = (const float*)(p.ws + WS_Z);
    bf16* QKA = (bf16*)(p.ws + WS_QKA);
    const float* rc = (const float*)(p.ws + WS_ROPE); const float* rs = rc + 1024;
    const float gq = p.in[I_GQK][(size_t)l * 128 + lane], gk = p.in[I_GQK][(size_t)l * 128 + 64 + lane];
    for (int t = gw; t < T; t += ngw) {
        const bool lat = t >= TCTX;
        float cs = 1.f, sn = 0.f;
        if (lat) {
            const int pos = (t - TCTX) & 2047, row = pos >> 6, colp = pos & 63, i = lane & 31;
            const int idx = (i < 16) ? row * 16 + i : colp * 16 + (i - 16);
            cs = rc[idx]; sn = rs[idx];
        }
#pragma unroll
        for (int slot = 0; slot < 10; ++slot) {
            const float z = Z[(size_t)t * ZW + slot * 64 + lane];
            float y = z;
            if (slot < 8) {
                const float r = rsqrtf(wave_sum(z * z) * (1.f / 64.f) + EPS);
                y = z * r * (slot < 6 ? gq : gk);
                if (!lat) {
                    if (slot >= 6) { const int b = t >> 8, s = t & 255; p.out[OUT_AK + ((size_t)(b * NL + l) * SEQ + s) * 128 + (slot - 6) * 64 + lane] = y; }
                } else {
                    const float pr = __shfl_xor(y, 32);
                    y = (lane < 32) ? y * cs - pr * sn : pr * sn + y * cs;
                }
            } else if (!lat) {
                const int b = t >> 8, s = t & 255; p.out[OUT_AV + ((size_t)(b * NL + l) * SEQ + s) * 128 + (slot - 8) * 64 + lane] = z;
            }
            QKA[(size_t)t * 640 + slot * 64 + lane] = f2bf(y);
        }
    }
}

struct ChunkId { int lat, b, h, dir, n, L, tok0; };
__device__ __forceinline__ ChunkId decode_cd(int cd) {
    ChunkId c;
    if (cd < 1024) { c.lat = 0; const int chain = cd >> 2; c.n = cd & 3; c.dir = chain & 1; c.h = (chain >> 1) & 3; c.b = chain >> 3; c.L = SEQ; c.tok0 = c.b * SEQ; }
    else { const int r = cd - 1024; c.lat = 1; const int chain = r >> 5; c.n = r & 31; c.dir = chain & 1; c.h = (chain >> 1) & 3; c.b = chain >> 3; c.L = LSEQ; c.tok0 = TCTX + c.b * LSEQ; }
    return c;
}

__device__ __forceinline__ void mm16(f32x4& acc, const float* Mx, int sm, const float* Nx, int sn, int nkb, int lane) {
    const float* pm = Mx + (lane & 15) * sm + (lane >> 4) * 4;
    const float* pn = Nx + (lane & 15) * sn + (lane >> 4) * 4;
    for (int kb = 0; kb < nkb; ++kb) {
        const f32x4 y = *(const f32x4*)(pm + kb * 16), x = *(const f32x4*)(pn + kb * 16);
        acc = __builtin_amdgcn_mfma_f32_16x16x4f32(x[0], y[0], acc, 0, 0, 0);
        acc = __builtin_amdgcn_mfma_f32_16x16x4f32(x[1], y[1], acc, 0, 0, 0);
        acc = __builtin_amdgcn_mfma_f32_16x16x4f32(x[2], y[2], acc, 0, 0, 0);
        acc = __builtin_amdgcn_mfma_f32_16x16x4f32(x[3], y[3], acc, 0, 0, 0);
    }
}
#define WAVE_LDS_FENCE() do { asm volatile("s_waitcnt lgkmcnt(0)" ::: "memory"); __builtin_amdgcn_wave_barrier(); } while (0)

__device__ __forceinline__ void d1_unit(const Params& p, int l, int cd, char* lds) {
    const int tid = otid(), lane = tid & 63, wave = tid >> 6;
    const ChunkId c = decode_cd(cd);
    const float* Z = (const float*)(p.ws + WS_Z);
    constexpr int S = 68;
    float* sq = (float*)lds;
    float* sk = sq + 64 * S;
    float* rT = sk + 64 * S;
    float* sa = rT + 128 * S;
    float* kgT = sa + 64 * S;
    float* Td = kgT + 64 * S;
    float* sg = Td + 4 * 16 * 20;
    float* sbeta = sg + 64;
    float* snrm = sbeta + 64;
    float* d1 = (float*)(p.ws + WS_D1) + (size_t)cd * 4 * 4096;
    const float* cw = p.in[I_CONVW] + (size_t)l * 3 * 768;
    float* raw = rT + 64 * S;
    const int s_lo = c.dir ? (c.L - 64 - c.n * 64) : c.n * 64;
#pragma unroll
    for (int q = 0; q < 7; ++q) {
        const int e = tid + NTHR * q;
        if (e < 66 * 48) {
            const int r = e / 48, c4 = e % 48, part = c4 >> 4, d4 = (c4 & 15) * 4;
            const int sx = s_lo - 1 + r;
            f32x4 v = (f32x4){0.f, 0.f, 0.f, 0.f};
            if (sx >= 0 && sx < c.L) v = *(const f32x4*)(Z + (size_t)(c.tok0 + sx) * ZW + ZC_BQKV + part * 256 + c.h * 64 + d4);
            *(f32x4*)(raw + r * 192 + c4 * 4) = v;
        }
    }
    __syncthreads();
    for (int e = tid; e < 64 * 192; e += NTHR) {
        const int i = e / 192, ch = e % 192, part = ch >> 6, d = ch & 63;
        const int r = (c.dir ? 63 - i : i) + 1;
        const int cc = part * 256 + c.h * 64 + d;
        const float y = silu_f(raw[(r - 1) * 192 + ch] * cw[cc] + raw[r * 192 + ch] * cw[768 + cc] + raw[(r + 1) * 192 + ch] * cw[1536 + cc]);
        if (part == 0) sq[i * S + d] = y; else if (part == 1) sk[i * S + d] = y; else rT[d * S + i] = y;
    }
    if (tid < 64) {
        const int pos = c.n * 64 + tid, s = c.dir ? (c.L - 1 - pos) : pos;
        const float* zr = Z + (size_t)(c.tok0 + s) * ZW;
        sbeta[tid] = sigmoid_f(zr[ZC_BBETA + c.dir * 4 + c.h]);
        const float al = p.in[I_ALOG][(size_t)l * 8 + c.dir * 4 + c.h], dtb = p.in[I_DTB][(size_t)l * 8 + c.dir * 4 + c.h];
        sg[tid] = -__expf(al) * softplus_f(zr[ZC_BALPHA + c.dir * 4 + c.h] + dtb);
    }
    __syncthreads();
    if (tid < 128) {
        const float* m = (tid < 64) ? sq + tid * S : sk + (tid - 64) * S;
        float ss = 0.f;
#pragma unroll 4
        for (int d4 = 0; d4 < 16; ++d4) { const f32x4 v = *(const f32x4*)(m + 4 * d4); ss += v[0] * v[0] + v[1] * v[1] + v[2] * v[2] + v[3] * v[3]; }
        snrm[tid] = rsqrtf(ss + EPS) * (tid < 64 ? 0.125f : 1.f);
    } else if (tid == 128) {
        float a = 0.f;
#pragma unroll 4
        for (int i = 0; i < 64; ++i) { a += sg[i]; sg[i] = a; }
    }
    __syncthreads();
    for (int e = tid; e < 64 * 64; e += NTHR) { const int i = e >> 6, d = e & 63; sq[i * S + d] *= snrm[i]; sk[i * S + d] *= snrm[64 + i]; }
    __syncthreads();
    const float gl = sg[63];
    f32x4 t4[4];
    {
        const float* Mx = (wave < 4) ? sk : sq;
#pragma unroll
        for (int q4 = 0; q4 < 4; ++q4) {
            const int tt = (wave & 3) * 4 + q4, mi = tt >> 2, ni = tt & 3;
            t4[q4] = (f32x4){0.f, 0.f, 0.f, 0.f};
            if (mi >= ni) mm16(t4[q4], Mx + mi * 16 * S, S, sk + ni * 16 * S, S, 4, lane);
        }
    }
    for (int e = tid; e < 64 * 64; e += NTHR) {
        const int d = e >> 6, i = e & 63;
        const float kv = sk[i * S + d], b = sbeta[i], gi = sg[i];
        rT[(64 + d) * S + i] = kv * b * __expf(gi);
        kgT[d * S + i] = kv * __expf(gl - gi);
        rT[d * S + i] *= b;
    }
    __syncthreads();
    {
#pragma unroll
        for (int q4 = 0; q4 < 4; ++q4) {
            const int tt = (wave & 3) * 4 + q4, mi = tt >> 2, ni = tt & 3;
            const int i = mi * 16 + (lane & 15), j0 = ni * 16 + (lane >> 4) * 4;
            const float gi = sg[i], bi = sbeta[i];
            f32x4 o;
#pragma unroll
            for (int r = 0; r < 4; ++r) {
                const int j = j0 + r;
                const float dec = (i >= j) ? __expf(gi - sg[j]) : 0.f;
                o[r] = (wave < 4) ? ((i > j) ? bi * t4[q4][r] * dec : 0.f) : t4[q4][r] * dec;
            }
            *(f32x4*)(((wave < 4) ? sk : sa) + i * S + j0) = o;
        }
    }
    for (int e = tid; e < 64 * 64; e += NTHR) { const int i = e >> 6, d = e & 63; sq[i * S + d] *= __expf(sg[i]); }
    __syncthreads();
    if (tid < 64) {
        const int b = tid >> 4, cc = tid & 15;
        const float* Lb = sk + (16 * b) * S + 16 * b;
        float x[16];
#pragma unroll
        for (int i = 0; i < 16; ++i) {
            float a = (i == cc) ? 1.f : 0.f;
#pragma unroll
            for (int j = 0; j < i; ++j) a -= Lb[i * S + j] * x[j];
            x[i] = a;
            Td[(b * 16 + i) * 20 + cc] = a;
        }
    }
    __syncthreads();
    {
        float* rw = rT + (16 * wave) * S;
        float* my = rw + (lane & 15) * S + (lane >> 4) * 4;
#pragma unroll 1
        for (int bi = 0; bi < 4; ++bi) {
            f32x4 acc = (f32x4){0.f, 0.f, 0.f, 0.f};
            mm16(acc, rw, S, sk + (16 * bi) * S, S, bi, lane);
            f32x4 r = *(const f32x4*)(my + 16 * bi);
            r = r - acc;
            *(f32x4*)(my + 16 * bi) = r;
            WAVE_LDS_FENCE();
            f32x4 acc2 = (f32x4){0.f, 0.f, 0.f, 0.f};
            mm16(acc2, rw + 16 * bi, S, Td + bi * 16 * 20, 20, 1, lane);
            WAVE_LDS_FENCE();
            *(f32x4*)(my + 16 * bi) = acc2;
            WAVE_LDS_FENCE();
        }
    }
    __syncthreads();
    const float decl = __expf(gl);
#pragma unroll 1
    for (int q8 = 0; q8 < 8; ++q8) {
        const int t = wave * 8 + q8, pi = t >> 4, tt = t & 15, mi = tt >> 2, ni = tt & 3;
        const float* Mx = (pi == 0) ? kgT : (pi == 1 ? rT : sa);
        const float* Nx = (pi == 1) ? kgT : ((pi == 3) ? rT : rT + 64 * S);
        f32x4 acc = (f32x4){0.f, 0.f, 0.f, 0.f};
        mm16(acc, Mx + mi * 16 * S, S, Nx + ni * 16 * S, S, 4, lane);
        const int m = mi * 16 + (lane & 15), n0 = ni * 16 + (lane >> 4) * 4;
        f32x4 o = acc;
        if (pi == 0) {
#pragma unroll
            for (int r = 0; r < 4; ++r) o[r] = ((m == n0 + r) ? decl : 0.f) - acc[r];
        } else if (pi == 2) {
            const f32x4 qv = *(const f32x4*)(sq + m * S + n0);
            o = qv - acc;
        }
        *(f32x4*)(d1 + pi * 4096 + m * 64 + n0) = o;
    }
    __syncthreads();
}

__device__ __forceinline__ void phase_p(const Params& p, int l, char* lds) {
    p_tokens(p, l);
    for (int cd = obid(); cd < NCD; cd += gridDim.x) d1_unit(p, l, cd, lds);
}

template <int NC>
__device__ __forceinline__ void d2_unit(const Params& p, int l, int lat, int chain, int slice, char* lds) {
    constexpr int S = 68, NT = (NC / 16) * 4, TPW = (NT + 7) / 8;
    const int tid = otid(), lane = tid & 63, wave = tid >> 6;
    const int dir = chain & 1, h = (chain >> 1) & 3, b = chain >> 3;
    const int nch = lat ? LSEQ / 64 : SEQ / 64;
    const int cd0 = lat ? 1024 + chain * 32 : chain * 4;
    const int c0 = slice * NC;
    float* Ab = (float*)lds;
    float* ST = Ab + 2 * 64 * S;
    const float* d1 = (const float*)(p.ws + WS_D1);
    float* STg = (float*)(p.ws + WS_ST);
    for (int e = tid; e < 64 * NC; e += NTHR) {
        const int k = e / NC, cc = e % NC;
        ST[cc * S + k] = lat ? p.in[I_SB][((((size_t)b * NL + l) * 2 + dir) * 4 + h) * 4096 + k * 64 + c0 + cc] : 0.f;
    }
    f32x4 ar[2];
#pragma unroll
    for (int q = 0; q < 2; ++q) { const int e4 = tid + NTHR * q; ar[q] = *(const f32x4*)(d1 + (size_t)cd0 * 4 * 4096 + e4 * 4); }
#pragma unroll
    for (int q = 0; q < 2; ++q) { const int e4 = tid + NTHR * q; *(f32x4*)(Ab + (e4 >> 4) * S + (e4 & 15) * 4) = ar[q]; }
    f32x4 btn[TPW];
#pragma unroll
    for (int q = 0; q < TPW; ++q) {
        const int t = wave * TPW + q;
        btn[q] = (f32x4){0.f, 0.f, 0.f, 0.f};
        if (t < NT) { const int mi = t >> 2, ni = t & 3; btn[q] = *(const f32x4*)(d1 + (size_t)cd0 * 4 * 4096 + 4096 + (c0 + mi * 16 + (lane & 15)) * 64 + ni * 16 + (lane >> 4) * 4); }
    }
    __syncthreads();
    for (int n = 0; n < nch; ++n) {
        const float* dn = d1 + (size_t)(cd0 + n) * 4 * 4096;
        float* Acur = Ab + (n & 1) * 64 * S;
        for (int e4 = tid; e4 < NC * 16; e4 += NTHR) {
            const int cc = e4 >> 4, k4 = (e4 & 15) * 4;
            *(f32x4*)(STg + (size_t)(cd0 + n) * 4096 + (c0 + cc) * 64 + k4) = *(const f32x4*)(ST + cc * S + k4);
        }
        if (n + 1 < nch) {
#pragma unroll
            for (int q = 0; q < 2; ++q) { const int e4 = tid + NTHR * q; ar[q] = *(const f32x4*)(dn + 4 * 4096 + e4 * 4); }
        }
        f32x4 res[TPW];
#pragma unroll
        for (int q = 0; q < TPW; ++q) {
            const int t = wave * TPW + q;
            if (t < NT) {
                const int mi = t >> 2, ni = t & 3;
                const int m = mi * 16 + (lane & 15), n0 = ni * 16 + (lane >> 4) * 4;
                res[q] = btn[q];
                if (n + 1 < nch) btn[q] = *(const f32x4*)(dn + 4 * 4096 + 4096 + (c0 + m) * 64 + n0);
                mm16(res[q], ST + mi * 16 * S, S, Acur + ni * 16 * S, S, 4, lane);
            }
        }
        __syncthreads();
#pragma unroll
        for (int q = 0; q < TPW; ++q) {
            const int t = wave * TPW + q;
            if (t < NT) {
                const int mi = t >> 2, ni = t & 3;
                const int m = mi * 16 + (lane & 15), n0 = ni * 16 + (lane >> 4) * 4;
                *(f32x4*)(ST + m * S + n0) = res[q];
            }
        }
        if (n + 1 < nch) {
            float* Anx = Ab + ((n + 1) & 1) * 64 * S;
#pragma unroll
            for (int q = 0; q < 2; ++q) { const int e4 = tid + NTHR * q; *(f32x4*)(Anx + (e4 >> 4) * S + (e4 & 15) * 4) = ar[q]; }
        }
        __syncthreads();
    }
    if (!lat) {
        for (int e = tid; e < 64 * NC; e += NTHR) {
            const int k = e / NC, cc = e % NC;
            p.out[OUT_SB + ((((size_t)b * NL + l) * 2 + dir) * 4 + h) * 4096 + k * 64 + c0 + cc] = ST[cc * S + k];
        }
    }
    __syncthreads();
}

__device__ __forceinline__ void d3_unit(const Params& p, int l, int u, char* lds) {
    constexpr int S = 68;
    const int tid = otid(), lane = tid & 63, wave = tid >> 6;
    int lat, b, h, n;
    if (u < 512) { lat = 0; b = u >> 4; h = (u >> 2) & 3; n = u & 3; } else { const int r = u - 512; lat = 1; b = r >> 7; h = (r >> 5) & 3; n = r & 31; }
    const int nch = lat ? 32 : 4;
    const int tok0 = (lat ? TCTX + b * LSEQ : b * SEQ) + n * 64;
    float* Cm = (float*)lds;
    float* Sm = Cm + 2 * 64 * S;
    float* osum = Sm + 2 * 64 * S;
    const float* d1 = (const float*)(p.ws + WS_D1);
    const float* STg = (const float*)(p.ws + WS_ST);
    int cdd[2];
#pragma unroll
    for (int dir = 0; dir < 2; ++dir) {
        const int chain = (b * 4 + h) * 2 + dir;
        cdd[dir] = (lat ? 1024 + chain * 32 : chain * 4) + (dir ? nch - 1 - n : n);
    }
#pragma unroll
    for (int q = 0; q < 4; ++q) {
        const int e4 = tid + NTHR * q, dir = e4 >> 10, r4 = e4 & 1023;
        const int cd = dir ? cdd[1] : cdd[0];
        *(f32x4*)(Cm + dir * 64 * S + (r4 >> 4) * S + (r4 & 15) * 4) = *(const f32x4*)(d1 + ((size_t)cd * 4 + 2) * 4096 + r4 * 4);
        *(f32x4*)(Sm + dir * 64 * S + (r4 >> 4) * S + (r4 & 15) * 4) = *(const f32x4*)(STg + (size_t)cd * 4096 + r4 * 4);
    }
    __syncthreads();
    const int dir = wave >> 2;
    const int cdw = dir ? cdd[1] : cdd[0];
    f32x4 res[4];
#pragma unroll
    for (int q = 0; q < 4; ++q) {
        const int t = (wave & 3) * 4 + q, mi = t >> 2, ni = t & 3;
        const int m = mi * 16 + (lane & 15), n0 = ni * 16 + (lane >> 4) * 4;
        res[q] = *(const f32x4*)(d1 + ((size_t)cdw * 4 + 3) * 4096 + m * 64 + n0);
        mm16(res[q], Cm + dir * 64 * S + mi * 16 * S, S, Sm + dir * 64 * S + ni * 16 * S, S, 4, lane);
    }
    if (dir == 0) {
#pragma unroll
        for (int q = 0; q < 4; ++q) { const int t = (wave & 3) * 4 + q, mi = t >> 2, ni = t & 3; *(f32x4*)(osum + (mi * 16 + (lane & 15)) * S + ni * 16 + (lane >> 4) * 4) = res[q]; }
    }
    __syncthreads();
    if (dir == 1) {
#pragma unroll
        for (int q = 0; q < 4; ++q) {
            const int t = (wave & 3) * 4 + q, mi = t >> 2, ni = t & 3;
            float* o = osum + (63 - (mi * 16 + (lane & 15))) * S + ni * 16 + (lane >> 4) * 4;
            f32x4 v = *(const f32x4*)o; v = v + res[q]; *(f32x4*)o = v;
        }
    }
    __syncthreads();
    {
        const int tok = tid >> 3, part = tid & 7, t = tok0 + tok;
        const f32x4 v0 = *(const f32x4*)(osum + tok * S + part * 8), v1 = *(const f32x4*)(osum + tok * S + part * 8 + 4);
        float ss = v0[0] * v0[0] + v0[1] * v0[1] + v0[2] * v0[2] + v0[3] * v0[3] + v1[0] * v1[0] + v1[1] * v1[1] + v1[2] * v1[2] + v1[3] * v1[3];
        ss += __shfl_xor(ss, 1); ss += __shfl_xor(ss, 2); ss += __shfl_xor(ss, 4);
        const float r = rsqrtf(ss * (1.f / 64.f) + EPS);
        const float* gz = (const float*)(p.ws + WS_Z) + (size_t)t * ZW + ZC_BG + h * 64 + part * 8;
        const float* gb = p.in[I_GONB] + (size_t)l * 64 + part * 8;
        const f32x4 z0 = *(const f32x4*)gz, z1 = *(const f32x4*)(gz + 4), g0 = *(const f32x4*)gb, g1 = *(const f32x4*)(gb + 4);
        float y[8];
#pragma unroll
        for (int e = 0; e < 4; ++e) { y[e] = v0[e] * r * g0[e] * silu_f(z0[e]); y[4 + e] = v1[e] * r * g1[e] * silu_f(z1[e]); }
        uint4 o; o.x = pk2(y[0], y[1]); o.y = pk2(y[2], y[3]); o.z = pk2(y[4], y[5]); o.w = pk2(y[6], y[7]);
        *(uint4*)((bf16*)(p.ws + WS_HY) + (size_t)t * D + 384 + h * 64 + part * 8) = o;
    }
    __syncthreads();
}

struct AttnSeg { const bf16* K; const bf16* V; int stride; int nkeys; };

__device__ __forceinline__ void attn_unit(const bf16* Q, int qstride, AttnSeg s0, AttnSeg s1, int mode, int R0, int kr0, const float* rpb_h, bf16* O, int ostride, char* lds) {
    const int tid = otid(), lane = tid & 63, wave = tid >> 6;
    const int qi = lane & 15, g = lane >> 4;
    bf16* KV = (bf16*)lds;
    float* rp = (float*)(KV + 4 * 64 * 72);
    if (mode == 1) { for (int i = tid; i < 465; i += NTHR) rp[i] = rpb_h[i]; }
    bf16x8 qf[2];
    qf[0] = *(const bf16x8*)(Q + (size_t)(wave * 16 + qi) * qstride + g * 8);
    qf[1] = *(const bf16x8*)(Q + (size_t)(wave * 16 + qi) * qstride + 32 + g * 8);
    float m = -INFINITY, lsum = 0.f;
    f32x4 o[4];
#pragma unroll
    for (int i = 0; i < 4; ++i) o[i] = (f32x4){0.f, 0.f, 0.f, 0.f};
    const int qr = R0 + (wave >> 2), qc = (wave & 3) * 16 + qi;
    const int rs = min(max(qr - 4, 0), 24), cst = min(max(qc - 8, 0), 48);
    const int nt0 = s0.nkeys >> 6, nt = nt0 + (s1.nkeys >> 6);
    const int lkey = tid >> 3, lcc = tid & 7;
    uint4 kreg, vreg;
    {
        kreg = *(const uint4*)(s0.K + (size_t)lkey * s0.stride + lcc * 8);
        vreg = *(const uint4*)(s0.V + (size_t)lkey * s0.stride + lcc * 8);
        bf16* Ks = KV; bf16* Vt = KV + 64 * 72;
        *(uint4*)(Ks + lkey * 72 + lcc * 8) = kreg;
        const unsigned w[4] = {vreg.x, vreg.y, vreg.z, vreg.w};
#pragma unroll
        for (int e = 0; e < 4; ++e) { Vt[(lcc * 8 + 2 * e) * 72 + lkey] = (bf16)(w[e] & 0xffffu); Vt[(lcc * 8 + 2 * e + 1) * 72 + lkey] = (bf16)(w[e] >> 16); }
    }
    __syncthreads();
    for (int ti = 0; ti < nt; ++ti) {
        const bf16* Ks = KV + (ti & 1) * (2 * 64 * 72); const bf16* Vt = Ks + 64 * 72;
        if (ti + 1 < nt) {
            const int tn = ti + 1; const bool sg1 = tn >= nt0;
            const bf16* Kp = sg1 ? s1.K : s0.K; const bf16* Vp = sg1 ? s1.V : s0.V; const int st = sg1 ? s1.stride : s0.stride;
            const int k0 = (sg1 ? tn - nt0 : tn) * 64;
            kreg = *(const uint4*)(Kp + (size_t)(k0 + lkey) * st + lcc * 8);
            vreg = *(const uint4*)(Vp + (size_t)(k0 + lkey) * st + lcc * 8);
        }
        const bool nb = (mode == 1 && ti < nt0);
        const int kr = kr0 + ti;
        if (!(nb && (kr < rs || kr >= rs + 8))) {
            f32x4 s[4];
#pragma unroll
            for (int kt = 0; kt < 4; ++kt) {
                s[kt] = (f32x4){0.f, 0.f, 0.f, 0.f};
#pragma unroll
                for (int kk = 0; kk < 2; ++kk) {
                    const bf16x8 kf = *(const bf16x8*)(Ks + (kt * 16 + qi) * 72 + kk * 32 + g * 8);
                    s[kt] = __builtin_amdgcn_mfma_f32_16x16x32_bf16(kf, qf[kk], s[kt], 0, 0, 0);
                }
            }
            float tmax = -INFINITY;
#pragma unroll
            for (int kt = 0; kt < 4; ++kt)
#pragma unroll
                for (int i = 0; i < 4; ++i) {
                    float v = s[kt][i] * 0.125f;
                    if (nb) {
                        const int kc = kt * 16 + 4 * g + i;
                        const int dc = min(max(kc - qc + 15, 0), 30);
                        v += rp[(kr - qr + 7) * 31 + dc];
                        if (kc < cst || kc >= cst + 16) v = -INFINITY;
                    }
                    s[kt][i] = v; tmax = fmaxf(tmax, v);
                }
            tmax = fmaxf(tmax, __shfl_xor(tmax, 16)); tmax = fmaxf(tmax, __shfl_xor(tmax, 32));
            const float mn = fmaxf(m, tmax);
            const float mu = (mn == -INFINITY) ? 0.f : mn;
            const float alpha = __expf(m - mu);
            m = mn;
            float ps = 0.f;
#pragma unroll
            for (int kt = 0; kt < 4; ++kt)
#pragma unroll
                for (int i = 0; i < 4; ++i) { const float pv = __expf(s[kt][i] - mu); s[kt][i] = pv; ps += pv; }
            lsum = lsum * alpha + ps;
#pragma unroll
            for (int dt = 0; dt < 4; ++dt) { o[dt][0] *= alpha; o[dt][1] *= alpha; o[dt][2] *= alpha; o[dt][3] *= alpha; }
#pragma unroll
            for (int pp = 0; pp < 2; ++pp) {
                union { bf16x8 v; unsigned u[4]; } pf;
                pf.u[0] = pk2(s[2 * pp][0], s[2 * pp][1]); pf.u[1] = pk2(s[2 * pp][2], s[2 * pp][3]);
                pf.u[2] = pk2(s[2 * pp + 1][0], s[2 * pp + 1][1]); pf.u[3] = pk2(s[2 * pp + 1][2], s[2 * pp + 1][3]);
#pragma unroll
                for (int dt = 0; dt < 4; ++dt) {
                    union { bf16x8 v; uint2 h[2]; } vf;
                    vf.h[0] = *(const uint2*)(Vt + (dt * 16 + qi) * 72 + (2 * pp) * 16 + 4 * g);
                    vf.h[1] = *(const uint2*)(Vt + (dt * 16 + qi) * 72 + (2 * pp + 1) * 16 + 4 * g);
                    o[dt] = __builtin_amdgcn_mfma_f32_16x16x32_bf16(vf.v, pf.v, o[dt], 0, 0, 0);
                }
            }
        }
        if (ti + 1 < nt) {
            bf16* Kn = KV + ((ti + 1) & 1) * (2 * 64 * 72); bf16* Vn = Kn + 64 * 72;
            *(uint4*)(Kn + lkey * 72 + lcc * 8) = kreg;
            const unsigned w[4] = {vreg.x, vreg.y, vreg.z, vreg.w};
#pragma unroll
            for (int e = 0; e < 4; ++e) { Vn[(lcc * 8 + 2 * e) * 72 + lkey] = (bf16)(w[e] & 0xffffu); Vn[(lcc * 8 + 2 * e + 1) * 72 + lkey] = (bf16)(w[e] >> 16); }
        }
        __syncthreads();
    }
    lsum += __shfl_xor(lsum, 16); lsum += __shfl_xor(lsum, 32);
    const float inv = 1.f / lsum;
#pragma unroll
    for (int dt = 0; dt < 4; ++dt) {
        uint2 w; w.x = pk2(o[dt][0] * inv, o[dt][1] * inv); w.y = pk2(o[dt][2] * inv, o[dt][3] * inv);
        *(uint2*)(O + (size_t)(wave * 16 + qi) * ostride + dt * 16 + 4 * g) = w;
    }
}

constexpr int MIX_BLAT = 64, MIX_ALAT = 192, MIX_CLAT = 192, MIX_BCTX = 256, MIX_ACTX = 384, MIX_CCTX = 384;
constexpr int MIX_TOTAL = MIX_BLAT + MIX_ALAT + MIX_CLAT + MIX_BCTX + MIX_ACTX + MIX_CCTX;

__device__ __forceinline__ void phase_mix(const Params& p, int l, char* lds, int rep) {
    unsigned* ctr = (unsigned*)(p.ws + WS_CTR) + l * 64 + rep * 16;
    int* su = (int*)(lds + LDS_BYTES - 16);
    const bf16* QKA = (const bf16*)(p.ws + WS_QKA);
    const bf16* CQ = (const bf16*)(p.ws + WS_CQKV);
    bf16* O = (bf16*)(p.ws + WS_O);
    for (;;) {
        __syncthreads();
        if (otid() == 0) *su = (int)atomicAdd(ctr, 1u);
        __syncthreads();
        int u = *su;
        if (u >= MIX_TOTAL) break;
        if (u < MIX_BLAT) { d2_unit<16>(p, l, 1, u >> 2, u & 3, lds); continue; } u -= MIX_BLAT;
        if (u >= MIX_ALAT + MIX_CLAT && u < MIX_ALAT + MIX_CLAT + MIX_BCTX) { d2_unit<64>(p, l, 0, u - MIX_ALAT - MIX_CLAT, 0, lds); continue; }
        int kind;
        if (u < MIX_ALAT) kind = 0; else if (u < MIX_ALAT + MIX_CLAT) { kind = 1; u -= MIX_ALAT; }
        else { u -= MIX_ALAT + MIX_CLAT + MIX_BCTX; if (u < MIX_ACTX) kind = 2; else { kind = 3; u -= MIX_ACTX; } }
        const bool lat = kind < 2, isA = (kind & 1) == 0;
        const int b = lat ? u / 96 : u / 12, h = lat ? (u % 96) / 16 : (u % 12) / 2, qt = lat ? u % 16 : u % 2;
        const int t0 = lat ? TCTX + b * LSEQ : b * SEQ;
        const int kvh = h / 3;
        int R0 = 0, lo = 0;
        AttnSeg s0, s1;
        const bf16* Qp; int qstride; bf16* Op;
        if (isA) {
            s0.K = QKA + (size_t)t0 * 640 + 384 + kvh * 64; s0.V = QKA + (size_t)t0 * 640 + 512 + kvh * 64; s0.stride = 640; s0.nkeys = lat ? LSEQ : SEQ;
            s1.K = (const bf16*)(p.ws + WS_CAK) + ((size_t)(b * NL + l) * 256) * 128 + kvh * 64; s1.V = (const bf16*)(p.ws + WS_CAV) + ((size_t)(b * NL + l) * 256) * 128 + kvh * 64; s1.stride = 128;
            Qp = QKA + (size_t)(t0 + qt * 128) * 640 + h * 64; qstride = 640; Op = O + (size_t)(t0 + qt * 128) * 768 + h * 64;
        } else {
            int hi = 4;
            if (lat) { R0 = 2 * qt; lo = min(max(R0 - 4, 0), 24); hi = min(max(R0 + 1 - 4, 0), 24) + 8; }
            s0.K = CQ + (size_t)(t0 + lo * 64) * CW + 384 + h * 64; s0.V = CQ + (size_t)(t0 + lo * 64) * CW + 768 + h * 64; s0.stride = CW; s0.nkeys = (hi - lo) * 64;
            s1.K = (const bf16*)(p.ws + WS_CCK) + ((size_t)(b * NL + l) * 256) * 384 + h * 64; s1.V = (const bf16*)(p.ws + WS_CCV) + ((size_t)(b * NL + l) * 256) * 384 + h * 64; s1.stride = 384;
            Qp = CQ + (size_t)(t0 + qt * 128) * CW + h * 64; qstride = CW; Op = O + (size_t)(t0 + qt * 128) * 768 + 384 + h * 64;
        }
        s1.nkeys = lat ? 256 : 0;
        attn_unit(Qp, qstride, s0, s1, kind == 1 ? 1 : 0, R0, lo, p.in[I_RPB] + ((size_t)l * 6 + h) * 465, Op, 768, lds);
    }
}


#define LAS __attribute__((address_space(3)))
#define XB_TMO      128
#define XB_XCNT(j)  (256  + 64 * (j))
#define XB_XSUB(j)  (1280 + 64 * (j))
#define XB_XGEN(j)  (2304 + 64 * (j))
#define XB_TOP      3328
#define XB_TOPGEN   3392
#define XCD_BAR_WORDS 3456
#define XB_SPIN_CAP (1u << 18)
__device__ __forceinline__ unsigned xb_ld(unsigned* p)              { return __hip_atomic_load(p, __ATOMIC_RELAXED, __HIP_MEMORY_SCOPE_AGENT); }
__device__ __forceinline__ unsigned xb_add(unsigned* p, unsigned v) { return __hip_atomic_fetch_add(p, v, __ATOMIC_RELAXED, __HIP_MEMORY_SCOPE_AGENT); }
__device__ __forceinline__ unsigned xb_xcc_id() { return (unsigned)__builtin_amdgcn_s_getreg((3 << 11) | 20) & 0xFu; }
#define XB_SPIN(cond, bar) do { unsigned _sp = 0; while (cond) { __builtin_amdgcn_s_sleep(1); \
    if ((++_sp & 255u) == 0u) { if (xb_ld(&(bar)[XB_TMO])) break; if (_sp > XB_SPIN_CAP) { atomicAdd(&(bar)[XB_TMO], 1u); break; } } } } while (0)
struct XcdBarrier { unsigned* bar; unsigned x; volatile LAS unsigned* st; };
__device__ __forceinline__ XcdBarrier xcd_barrier_post(unsigned* bar, volatile LAS unsigned* st) {
    XcdBarrier b; b.bar = bar; b.x = xb_xcc_id(); b.st = st;
    if (threadIdx.x == 0) (void)xb_add(&bar[XB_XCNT(b.x)], 1u);
    return b;
}
__device__ __forceinline__ void xcd_barrier_complete(unsigned* bar, unsigned x, unsigned& nloc, unsigned& nx) {
    const unsigned G = gridDim.x * gridDim.y * gridDim.z;
    unsigned sum, cnt, mine, sp = 0u;
    for (;;) {
        sum = 0u; cnt = 0u; mine = 0u;
#pragma unroll
        for (unsigned j = 0; j < 16; ++j) { const unsigned c = xb_ld(&bar[XB_XCNT(j)]); sum += c; cnt += (c > 0u) ? 1u : 0u; mine = (j == x) ? c : mine; }
        if (sum == G) break;
        __builtin_amdgcn_s_sleep(1);
        if ((++sp & 255u) == 0u) { if (xb_ld(&bar[XB_TMO])) break; if (sp > XB_SPIN_CAP) { atomicAdd(&bar[XB_TMO], 1u); break; } }
    }
    nloc = mine > 0u ? mine : 1u; nx = cnt > 0u ? cnt : 1u;
}
__device__ __forceinline__ void xcd_barrier(const XcdBarrier& b) {
    asm volatile("s_waitcnt vmcnt(0)" ::: "memory");
    __syncthreads();
    if (threadIdx.x == 0) {
        unsigned* bar = b.bar;
        __builtin_amdgcn_s_waitcnt(0);
        unsigned nloc = b.st[0], nx = b.st[1];
        if (nloc == 0u) { xcd_barrier_complete(bar, b.x, nloc, nx); b.st[0] = nloc; b.st[1] = nx; }
        const unsigned old = xb_add(&bar[XB_XSUB(b.x)], 1u);
        const unsigned gen = old / nloc;
        if (old + 1u == (gen + 1u) * nloc) {
            __builtin_amdgcn_fence(__ATOMIC_RELEASE, "agent");
            asm volatile("s_waitcnt vmcnt(0)" ::: "memory");
            const unsigned og = xb_add(&bar[XB_TOP], 1u);
            const unsigned tg = og / nx;
            if (og + 1u == (tg + 1u) * nx) xb_add(&bar[XB_TOPGEN], 1u);
            else XB_SPIN(xb_ld(&bar[XB_TOPGEN]) == tg, bar);
            __builtin_amdgcn_fence(__ATOMIC_ACQUIRE, "agent");
            xb_add(&bar[XB_XGEN(b.x)], 1u);
            asm volatile("s_waitcnt vmcnt(0)" ::: "memory");
        } else {
            XB_SPIN(xb_ld(&bar[XB_XGEN(b.x)]) == gen, bar);
            __builtin_amdgcn_fence(__ATOMIC_ACQUIRE, "agent");
            asm volatile("s_waitcnt vmcnt(0)" ::: "memory");
        }
    }
    __syncthreads();
}

constexpr int PH_PER_LAYER = 9;
constexpr int N_PHASES = 1 + PH_PER_LAYER * DBG_LAYERS + 1;

__global__ void __launch_bounds__(NTHR) mega_kernel(Params p) {
    extern __shared__ __attribute__((aligned(16))) char lds[];
    cg::grid_group grid = cg::this_grid();
    volatile LAS unsigned* xst = (volatile LAS unsigned*)((LAS char*)lds + (LDS_BYTES - 64));
    if (threadIdx.x < 4) xst[threadIdx.x] = 0u;
    __syncthreads();
    const XcdBarrier xbar = xcd_barrier_post((unsigned*)(p.ws + WS_BAR), xst);
    for (int ph = p.ph_lo; ph < p.ph_hi; ++ph) {
        if (ph > p.ph_lo) { if (ph == p.ph_lo + 1) grid.sync(); else xcd_barrier(xbar); }
        if (ph == 0) { phase_prologue(p, lds); continue; }
        const bool last = (ph == N_PHASES - 1);
        const int l = last ? DBG_LAYERS : (ph - 1) / PH_PER_LAYER, s = last ? 9 : (ph - 1) % PH_PER_LAYER;
        for (int rep = 0; rep < (((REPEAT_MASK >> s) & 1) ? 2 : 1); ++rep) {
        if (rep) xcd_barrier(xbar);
        if (s == 0) phase_wconv(p, l, lds);
        if (s == 0 || s == 6 || s == 9) phase_rows(p, l, s == 6 ? 1 : 0);
        else if (s == 1) {
            pg8::Gemm g{(const bf16*)(p.ws + WS_HY), (const bf16*)(p.ws + WS_WIN), T, INWP, D}; pg8::StaticOrder S; S.init(T, INWP, gridDim.x, obid());
            pg8::EpiInProj E{(float*)(p.ws + WS_Z), (bf16*)(p.ws + WS_CQKV), p.out + OUT_CK, p.out + OUT_CV, l};
            pg8::gemm_phase<pg8::EpiInProj, pg8::StaticOrder, true, true>((pg8::LdsPtr)lds, g, S, E);
        }
        else if (s == 2) phase_p(p, l, lds);
        else if (s == 3) phase_mix(p, l, lds, rep);
        else if (s == 4) phase_ybuild(p, l, lds);
        else if (s == 7) {
            pg8::Gemm g{(const bf16*)(p.ws + WS_HY), (const bf16*)(p.ws + WS_WGU), T, GUW, D}; pg8::StaticOrder S; S.init(T, GUW, gridDim.x, obid());
            pg8::EpiSwiGLU E{(bf16*)(p.ws + WS_D1), DFF};
            pg8::gemm_phase<pg8::EpiSwiGLU, pg8::StaticOrder, true, true>((pg8::LdsPtr)lds, g, S, E);
        }
        else {
            const bool dn = (s == 8);
            pg8::Gemm g{(const bf16*)(p.ws + (dn ? WS_D1 : WS_HY)), (const bf16*)(p.ws + (dn ? WS_WDN : WS_WOUT)), T, D, dn ? DFF : D}; pg8::StaticOrder S; S.init(T, D, gridDim.x, obid());
            pg8::EpiF32 E{(float*)(p.ws + WS_Z), D};
            pg8::gemm_phase<pg8::EpiF32, pg8::StaticOrder, true, true>((pg8::LdsPtr)lds, g, S, E);
        }
        }
    }
}

extern "C" void kernel_launch(void* const* d_in, const int* in_sizes, int n_in, void* d_out, int out_size, void* d_ws, size_t ws_size, hipStream_t stream) {
    static int grid = 0;
    if (grid == 0) {
        if (n_in != 24 || ws_size < WS_END) { fprintf(stderr, "kernel_launch: unexpected n_in %d or ws_size %zu (need %zu)\n", n_in, ws_size, (size_t)WS_END); grid = -1; return; }
        int dev = 0, cus = 0, per_cu = 0;
        (void)hipGetDevice(&dev);
        (void)hipDeviceGetAttribute(&cus, hipDeviceAttributeMultiprocessorCount, dev);
        (void)hipFuncSetAttribute((const void*)mega_kernel, hipFuncAttributeMaxDynamicSharedMemorySize, LDS_BYTES);
        (void)hipOccupancyMaxActiveBlocksPerMultiprocessor(&per_cu, (const void*)mega_kernel, NTHR, LDS_BYTES);
        if (per_cu < 1) { fprintf(stderr, "kernel_launch: occupancy query says %d blocks per CU\n", per_cu); grid = -1; return; }
        grid = cus;
    }
    if (grid < 0) return;
    (void)hipMemsetAsync((char*)d_ws + WS_CTR, 0, WS_ZERO_BYTES, stream);
    Params p{};
    for (int i = 0; i < 24; ++i) p.in[i] = (const float*)d_in[i];
    p.out = (float*)d_out; p.ws = (unsigned char*)d_ws; p.ph_lo = 0; p.ph_hi = N_PHASES;
    void* args[] = {&p};
    hipError_t e = hipLaunchCooperativeKernel((const void*)mega_kernel, dim3(grid), dim3(NTHR), args, LDS_BYTES, stream);
    if (e != hipSuccess) fprintf(stderr, "cooperative launch failed: %s (grid %d)\n", hipGetErrorString(e), grid);
}
```
